# Optimizing an MI355X kernel written in HIP

```python
import jax, jax.numpy as jnp
from jax import lax
import numpy as np

D_MODEL = 2048
BATCH = 4
SEQ = 2048
DEPTH = 1

MIX_WIDTH = D_MODEL
DIFF_WIDTH = MIX_WIDTH // 2
MLA_WIDTH = MIX_WIDTH - DIFF_WIDTH
DIFF_HEAD_DIM = 64
DIFF_V_DIM = 2 * DIFF_HEAD_DIM
DIFF_HEADS = DIFF_WIDTH // DIFF_V_DIM
DIFF_ROT_DIM = DIFF_HEAD_DIM // 4
ROPE_THETA = 500000.0
LAMBDA_INIT_STD = 0.1
MLA_V_DIM = 128
MLA_HEADS = MLA_WIDTH // MLA_V_DIM
MLA_NOPE_DIM = 128
MLA_ROPE_DIM = 64
MLA_ROPE_THETA = 10000.0
Q_LORA_RANK = D_MODEL // 4
KV_LORA_RANK = D_MODEL // 8
D_FF = 4 * D_MODEL
Q_BLOCK = 128
NORM_EPS = 1e-6
N_MOD = 6

DIFF_Q_COLS = DIFF_HEADS * 2 * DIFF_HEAD_DIM
DIFF_K_COLS = DIFF_HEADS * 2 * DIFF_HEAD_DIM
DIFF_V_COLS = DIFF_HEADS * DIFF_V_DIM
IN_COLS = DIFF_Q_COLS + DIFF_K_COLS + DIFF_V_COLS + Q_LORA_RANK + KV_LORA_RANK + MLA_ROPE_DIM
IN_SPLITS = (DIFF_Q_COLS,
             DIFF_Q_COLS + DIFF_K_COLS,
             DIFF_Q_COLS + DIFF_K_COLS + DIFF_V_COLS,
             DIFF_Q_COLS + DIFF_K_COLS + DIFF_V_COLS + Q_LORA_RANK,
             DIFF_Q_COLS + DIFF_K_COLS + DIFF_V_COLS + Q_LORA_RANK + KV_LORA_RANK)

kernel_name = "hybrid_diffattn_mla_sqrelu_adaln_encoder"


def rmsnorm(x, g):
    x32 = x.astype(jnp.float32)
    y = x32 * lax.rsqrt(jnp.mean(x32 * x32, axis=-1, keepdims=True) + NORM_EPS)
    return (y * g.astype(jnp.float32)).astype(x.dtype)


def modulate(h, shift, scale):
    return h * (1.0 + scale[:, None, :]) + shift[:, None, :]


def rope_cos_sin(positions, dim, theta):
    inv = 1.0 / (theta ** (jnp.arange(0, dim, 2, dtype=jnp.float32) / dim))
    ang = positions.astype(jnp.float32)[..., None] * inv
    ang = jnp.concatenate([ang, ang], axis=-1)
    return jnp.cos(ang), jnp.sin(ang)


def apply_rope(x, cos, sin):
    half = x.shape[-1] // 2
    x1, x2 = x[..., :half], x[..., half:]
    rot = jnp.concatenate([-x2, x1], axis=-1)
    return (x.astype(jnp.float32) * cos + rot.astype(jnp.float32) * sin).astype(x.dtype)


def partial_rope(x, cos, sin, rot_dim):
    return jnp.concatenate([apply_rope(x[..., :rot_dim], cos, sin), x[..., rot_dim:]], axis=-1)


def to_blocks(a):
    b, s = a.shape[0], a.shape[1]
    a = a.reshape((b, s // Q_BLOCK, Q_BLOCK) + a.shape[2:])
    return jnp.moveaxis(a, 1, 0)


def from_blocks(a):
    a = jnp.moveaxis(a, 0, 1)
    return a.reshape((a.shape[0], a.shape[1] * a.shape[2]) + a.shape[3:])


def diff_attention(q, k, v, lam):
    scale = DIFF_HEAD_DIM ** -0.5
    lam32 = lam.astype(jnp.float32)

    def block(qb):
        s = jnp.einsum('bqhcd,bkhcd->bhcqk', qb * scale, k).astype(jnp.float32)
        p = jax.nn.softmax(s, axis=-1)
        a = p[:, :, 0] - lam32 * p[:, :, 1]
        return jnp.einsum('bhqk,bkhe->bqhe', a.astype(v.dtype), v)

    return from_blocks(lax.map(block, to_blocks(q)))


def mla_attention(q_nope, q_rope, k_nope, k_rope, v):
    scale = (MLA_NOPE_DIM + MLA_ROPE_DIM) ** -0.5

    def block(args):
        qn, qr = args
        s = (jnp.einsum('bqhd,bkhd->bhqk', qn, k_nope)
             + jnp.einsum('bqhr,bkr->bhqk', qr, k_rope)).astype(jnp.float32) * scale
        p = jax.nn.softmax(s, axis=-1)
        return jnp.einsum('bhqk,bkhe->bqhe', p.astype(v.dtype), v)

    return from_blocks(lax.map(block, (to_blocks(q_nope), to_blocks(q_rope))))


def setup_inputs(seed: int = 0) -> dict:
    key = jax.random.key(seed)
    ks = jax.random.split(key, 24)
    f32 = jnp.float32

    def nrm(k, shape, fan_in):
        return jax.random.normal(k, shape, f32) * (fan_in ** -0.5)

    def gain(k, shape):
        return 1.0 + 0.02 * jax.random.normal(k, shape, f32)

    x = jax.random.normal(ks[0], (BATCH, SEQ, D_MODEL), f32)
    c = jax.random.normal(ks[1], (BATCH, D_MODEL), f32)
    positions = (jnp.arange(SEQ, dtype=jnp.int32)[None, :]
                 + jax.random.randint(ks[2], (BATCH, 1), 0, 1024, dtype=jnp.int32))
    return {
        "x": x,
        "c": c,
        "positions": positions,
        "w_ada": nrm(ks[3], (DEPTH, D_MODEL, N_MOD * D_MODEL), D_MODEL),
        "b_ada": 0.02 * jax.random.normal(ks[4], (DEPTH, N_MOD * D_MODEL), f32),
        "g_norm_mix": gain(ks[5], (DEPTH, D_MODEL)),
        "w_in": nrm(ks[6], (DEPTH, D_MODEL, IN_COLS), D_MODEL),
        "lambda_q1": LAMBDA_INIT_STD * jax.random.normal(ks[7], (DEPTH, DIFF_HEAD_DIM), f32),
        "lambda_k1": LAMBDA_INIT_STD * jax.random.normal(ks[8], (DEPTH, DIFF_HEAD_DIM), f32),
        "lambda_q2": LAMBDA_INIT_STD * jax.random.normal(ks[9], (DEPTH, DIFF_HEAD_DIM), f32),
        "lambda_k2": LAMBDA_INIT_STD * jax.random.normal(ks[10], (DEPTH, DIFF_HEAD_DIM), f32),
        "g_diff_sub": gain(ks[11], (DEPTH, DIFF_V_DIM)),
        "g_q_a": gain(ks[12], (DEPTH, Q_LORA_RANK)),
        "w_q_b": nrm(ks[13], (DEPTH, Q_LORA_RANK, MLA_HEADS * (MLA_NOPE_DIM + MLA_ROPE_DIM)), Q_LORA_RANK),
        "g_kv_a": gain(ks[14], (DEPTH, KV_LORA_RANK)),
        "w_kv_b": nrm(ks[15], (DEPTH, KV_LORA_RANK, MLA_HEADS * (MLA_NOPE_DIM + MLA_V_DIM)), KV_LORA_RANK),
        "w_out": nrm(ks[16], (DEPTH, MIX_WIDTH, D_MODEL), MIX_WIDTH),
        "g_norm_ffn": gain(ks[17], (DEPTH, D_MODEL)),
        "w_ff1": nrm(ks[18], (DEPTH, D_MODEL, D_FF), D_MODEL),
        "w_ff2": nrm(ks[19], (DEPTH, D_FF, D_MODEL), D_FF),
        "g_final": gain(ks[20], (D_MODEL,)),
    }


def reference(x, c, positions, w_ada, b_ada, g_norm_mix, w_in, lambda_q1, lambda_k1,
              lambda_q2, lambda_k2, g_diff_sub, g_q_a, w_q_b, g_kv_a, w_kv_b, w_out,
              g_norm_ffn, w_ff1, w_ff2, g_final):
    b, s, _ = x.shape
    cos_d, sin_d = rope_cos_sin(positions, DIFF_ROT_DIM, ROPE_THETA)
    cos_d, sin_d = cos_d[:, :, None, None, :], sin_d[:, :, None, None, :]
    cos_m, sin_m = rope_cos_sin(positions, MLA_ROPE_DIM, MLA_ROPE_THETA)
    silu_c = jax.nn.silu(c)

    for l in range(DEPTH):
        lambda_init = 0.8 - 0.6 * float(np.exp(-0.3 * l))
        mod = silu_c @ w_ada[l] + b_ada[l]
        shift_m, scale_m, gate_m, shift_f, scale_f, gate_f = jnp.split(mod, N_MOD, axis=-1)

        h = modulate(rmsnorm(x, g_norm_mix[l]), shift_m, scale_m)
        proj = h @ w_in[l]
        dq, dk, dv, q_lat, kv_lat, k_pe = jnp.split(proj, IN_SPLITS, axis=-1)

        dq = partial_rope(dq.reshape(b, s, DIFF_HEADS, 2, DIFF_HEAD_DIM), cos_d, sin_d, DIFF_ROT_DIM)
        dk = partial_rope(dk.reshape(b, s, DIFF_HEADS, 2, DIFF_HEAD_DIM), cos_d, sin_d, DIFF_ROT_DIM)
        dv = dv.reshape(b, s, DIFF_HEADS, DIFF_V_DIM)
        lam = (jnp.exp(jnp.sum(lambda_q1[l].astype(jnp.float32) * lambda_k1[l].astype(jnp.float32)))
               - jnp.exp(jnp.sum(lambda_q2[l].astype(jnp.float32) * lambda_k2[l].astype(jnp.float32)))
               + lambda_init)
        o_diff = diff_attention(dq, dk, dv, lam)
        o_diff = rmsnorm(o_diff, g_diff_sub[l]) * (1.0 - lambda_init)
        o_diff = o_diff.reshape(b, s, DIFF_WIDTH)

        cq = rmsnorm(q_lat, g_q_a[l])
        q = (cq @ w_q_b[l]).reshape(b, s, MLA_HEADS, MLA_NOPE_DIM + MLA_ROPE_DIM)
        q_nope = q[..., :MLA_NOPE_DIM]
        q_rope = apply_rope(q[..., MLA_NOPE_DIM:], cos_m[:, :, None, :], sin_m[:, :, None, :])
        ckv = rmsnorm(kv_lat, g_kv_a[l])
        kv = (ckv @ w_kv_b[l]).reshape(b, s, MLA_HEADS, MLA_NOPE_DIM + MLA_V_DIM)
        k_nope, v_mla = kv[..., :MLA_NOPE_DIM], kv[..., MLA_NOPE_DIM:]
        k_rope = apply_rope(k_pe, cos_m, sin_m)
        o_mla = mla_attention(q_nope, q_rope, k_nope, k_rope, v_mla).reshape(b, s, MLA_WIDTH)

        mix = jnp.concatenate([o_diff, o_mla], axis=-1) @ w_out[l]
        x = x + gate_m[:, None, :] * mix

        h = modulate(rmsnorm(x, g_norm_ffn[l]), shift_f, scale_f)
        f = jnp.square(jax.nn.relu(h @ w_ff1[l])) @ w_ff2[l]
        x = x + gate_f[:, None, :] * f

    return rmsnorm(x, g_final)
```

```cpp
#include <hip/hip_runtime.h>
#include <cstdio>
#include <cstdint>

namespace pg8 {
#define PG8_LAS __attribute__((address_space(3)))
typedef unsigned short bf16_t;
typedef short bf16x8 __attribute__((ext_vector_type(8)));
typedef float f32x4 __attribute__((ext_vector_type(4)));
typedef unsigned u32x4 __attribute__((ext_vector_type(4)));
constexpr int BM = 256, BK = 64, HALF = 128, HTB = HALF * BK * 2  , STAGE_BYTES = 8 * HTB, NXCD = 8, WGM = 8;

__host__ __device__ __forceinline__ int lds_byte(int r, int c) { const int st = (r >> 4) * 2 + (c >> 5), rr = r & 15, cc = c & 31, ob = rr * 64 + cc * 2; return st * 1024 + (ob ^ (((ob >> 9) & 1) << 5)); }
__host__ __device__ __forceinline__ void stage_rc(int b, int& R, int& C) { const int st = b / 1024, sb = b % 1024, swz = sb ^ (((sb >> 9) & 1) << 5); R = (st >> 1) * 16 + swz / 64; C = (st & 1) * 32 + (swz % 64) / 2; }
__host__ __device__ __forceinline__ int perm32(int rho) { const int n = rho >> 4, i = rho & 15; return 8 * (i >> 2) + 4 * n + (i & 3); }

struct Unit { int pm, pn; };
struct Gemm { const bf16_t* A; const bf16_t* Bt; int M, N, K; };

struct StaticOrder {
    int nM, nN, nwg, G, c;
    __host__ __device__ void init(int M, int N, int G_, int c_) { nM = M / BM; nN = N / BM; nwg = nM * nN; G = G_; c = c_; }
    __host__ __device__ bool next(int i, Unit& u) const {
        const long L = (long)i * G + c; if (L >= nwg) return false;
        int wgid = (int)L; { const int q = nwg / NXCD, r = nwg % NXCD, xcd = wgid % NXCD, off = wgid / NXCD; wgid = (xcd < r ? xcd * (q + 1) : r * (q + 1) + (xcd - r) * q) + off; }
        const int nig = WGM * nN, gid = wgid / nig, fm = gid * WGM, gsz = (nM - fm) < WGM ? (nM - fm) : WGM;
        u.pm = fm + ((wgid % nig) % gsz); u.pn = (wgid % nig) / gsz; return true;
    }
    __device__ __forceinline__ void a_ready(const Unit&) const {}
    __device__ __forceinline__ void done(const Unit&) const {}
};
__device__ __forceinline__ unsigned cvt_pk_bf16(float lo, float hi) { unsigned r; asm volatile("v_cvt_pk_bf16_f32 %0, %1, %2" : "=v"(r) : "v"(lo), "v"(hi)); return r; }
typedef float f32x2 __attribute__((ext_vector_type(2)));
template <class Epi, class Sched, bool ALIGN_EPI = false, bool SP2 = false>
__device__ __forceinline__ void gemm_phase(PG8_LAS unsigned char* lds, const Gemm g, const Sched& S, const Epi& E) {
    int tid_ = threadIdx.x; asm volatile("" : "+v"(tid_));
    const int tid = tid_, wid = __builtin_amdgcn_readfirstlane(tid >> 6), lane = tid & 63, wr = wid >> 2, wc = wid & 3, fr = lane & 15, fq = lane >> 4;
    const int K = g.K, nt = K / BK;
    unsigned voffA[2], voffB[2];
#pragma unroll
    for (int i = 0; i < 2; ++i) { int R, C; stage_rc(tid * 16 + i * 8192, R, C); const int Rb = Epi::PERM ? ((R & ~31) + perm32(R & 31)) : R;
        voffA[i] = (unsigned)(R * K + C) * 2u; voffB[i] = (unsigned)(Rb * K + C) * 2u; }
    const size_t kstep = (size_t)(BK * 2);
    const size_t hstep = (size_t)HALF * K * 2;
    const size_t tstep = 2 * hstep;
    const unsigned ldsw = (unsigned)wid * 1024u;
    const int aoff = lds_byte(wr * 64 + fr, fq * 8), boff = lds_byte(wc * 32 + fr, fq * 8);
#define PG8_SA(b, h) (((b) * 2 + (h)) * HTB)
#define PG8_SB(b, h) ((4 + (b) * 2 + (h)) * HTB)
#define PG8_STAGE(bufoff, gbase, voff) do { _Pragma("unroll") for (int _i = 0; _i < 2; ++_i) \
        __builtin_amdgcn_global_load_lds((const unsigned*)((const char*)(gbase) + (voff)[_i]), (PG8_LAS unsigned*)(lds + (bufoff) + ldsw + _i * 8192), 16, 0, 0); } while (0)
#define PG8_LDA(dst, b, h) do { _Pragma("unroll") for (int m = 0; m < 4; ++m) _Pragma("unroll") for (int k = 0; k < 2; ++k) dst[m][k] = *(const PG8_LAS bf16x8*)(lds + PG8_SA(b, h) + aoff + m * 2048 + k * 1024); } while (0)
#define PG8_LDB(dst, b, h) do { _Pragma("unroll") for (int n = 0; n < 2; ++n) _Pragma("unroll") for (int k = 0; k < 2; ++k) dst[n][k] = *(const PG8_LAS bf16x8*)(lds + PG8_SB(b, h) + boff + n * 2048 + k * 1024); } while (0)
#define PG8_MMA(ai, bj, At, Bt) do { __builtin_amdgcn_s_setprio(1); _Pragma("unroll") for (int m = 0; m < 4; ++m) _Pragma("unroll") for (int n = 0; n < 2; ++n) _Pragma("unroll") for (int k = 0; k < 2; ++k) \
        acc[ai][bj][m][n] = __builtin_amdgcn_mfma_f32_16x16x32_bf16(Bt[n][k], At[m][k], acc[ai][bj][m][n], 0, 0, 0); __builtin_amdgcn_s_setprio(0); } while (0)
#define PG8_WAIT_V(n) asm volatile("s_waitcnt vmcnt(" #n ")" ::: "memory")
#define PG8_WAIT_L(n) asm volatile("s_waitcnt lgkmcnt(" #n ")" ::: "memory")
#define PG8_BAR __builtin_amdgcn_s_barrier()
#define PG8_SCHED __builtin_amdgcn_sched_barrier(0)
    Unit cur, nxt; int ui = 0;
    if (!S.next(0, cur)) return;
    f32x4 acc[2][2][4][2];
#pragma unroll
    for (int a = 0; a < 2; ++a)
#pragma unroll
        for (int b = 0; b < 2; ++b)
#pragma unroll
            for (int m = 0; m < 4; ++m)
#pragma unroll
                for (int n = 0; n < 2; ++n) acc[a][b][m][n] = (f32x4){0.f, 0.f, 0.f, 0.f};
    bf16x8 At[4][2], B0[2][2], B1[2][2];
    const char* cA = (const char*)g.A + (size_t)cur.pm * tstep; const char* cB = (const char*)g.Bt + (size_t)cur.pn * tstep;
    S.a_ready(cur);
    if constexpr (SP2) {
        PG8_STAGE(PG8_SB(0, 0), cB, voffB); PG8_STAGE(PG8_SB(0, 1), cB + hstep, voffB); PG8_STAGE(PG8_SA(0, 0), cA, voffA); PG8_STAGE(PG8_SA(0, 1), cA + hstep, voffA);
        if (wr == 1) PG8_BAR;
        PG8_WAIT_V(2); PG8_BAR;
        PG8_STAGE(PG8_SB(1, 0), cB + kstep, voffB); PG8_STAGE(PG8_SA(1, 0), cA + kstep, voffA); PG8_STAGE(PG8_SB(1, 1), cB + hstep + kstep, voffB);
        PG8_WAIT_V(6); PG8_BAR;
    } else {
        PG8_STAGE(PG8_SB(0, 0), cB, voffB); PG8_STAGE(PG8_SA(0, 0), cA, voffA); PG8_STAGE(PG8_SB(0, 1), cB + hstep, voffB); PG8_STAGE(PG8_SA(0, 1), cA + hstep, voffA);
        if (wr == 1) PG8_BAR;
        PG8_WAIT_V(4); PG8_BAR;
        PG8_STAGE(PG8_SB(1, 0), cB + kstep, voffB); PG8_STAGE(PG8_SA(1, 0), cA + kstep, voffA); PG8_STAGE(PG8_SB(1, 1), cB + hstep + kstep, voffB);
        PG8_WAIT_V(6); PG8_BAR;
    }
    for (;;) {
        const bool has_next = S.next(ui + 1, nxt);
        const char* nA = has_next ? (const char*)g.A + (size_t)nxt.pm * tstep : cA; const char* nB = has_next ? (const char*)g.Bt + (size_t)nxt.pn * tstep : cB;
        for (int t = 0; t < nt; t += 2) {
            const bool last = (t == nt - 2);
            const char* a1 = cA + (size_t)(t + 1) * kstep;
            const char* a2 = last ? nA : cA + (size_t)(t + 2) * kstep; const char* b2 = last ? nB : cB + (size_t)(t + 2) * kstep;
            const char* a3 = a2 + kstep; const char* b3 = b2 + kstep;
            if (last && has_next) S.a_ready(nxt);
            if constexpr (SP2) {
            PG8_LDB(B0, 0, 0); PG8_LDB(B1, 0, 1); PG8_SCHED; PG8_LDA(At, 0, 0); PG8_STAGE(PG8_SA(1, 1), a1 + hstep, voffA);
            PG8_WAIT_V(8); PG8_WAIT_L(0); PG8_BAR; PG8_MMA(0, 0, At, B0); PG8_MMA(0, 1, At, B1); PG8_BAR; PG8_SCHED;
            PG8_LDA(At, 0, 1); PG8_STAGE(PG8_SB(0, 0), b2, voffB); PG8_STAGE(PG8_SB(0, 1), b2 + hstep, voffB); PG8_STAGE(PG8_SA(0, 0), a2, voffA);
            PG8_WAIT_V(8); PG8_WAIT_L(0); PG8_BAR; PG8_MMA(1, 0, At, B0); PG8_MMA(1, 1, At, B1); PG8_BAR; PG8_SCHED;
            PG8_LDB(B0, 1, 0); PG8_LDB(B1, 1, 1); PG8_SCHED; PG8_LDA(At, 1, 0); PG8_STAGE(PG8_SA(0, 1), a2 + hstep, voffA);
            PG8_WAIT_V(8); PG8_WAIT_L(0); PG8_BAR; PG8_MMA(0, 0, At, B0); PG8_MMA(0, 1, At, B1); PG8_BAR; PG8_SCHED;
            PG8_LDA(At, 1, 1); PG8_STAGE(PG8_SB(1, 0), b3, voffB); PG8_STAGE(PG8_SB(1, 1), b3 + hstep, voffB); PG8_STAGE(PG8_SA(1, 0), a3, voffA);
            PG8_WAIT_V(8); PG8_WAIT_L(0); PG8_BAR; PG8_MMA(1, 0, At, B0); PG8_MMA(1, 1, At, B1); PG8_BAR; PG8_SCHED;
            } else {
            PG8_LDB(B0, 0, 0); PG8_SCHED; PG8_LDA(At, 0, 0); PG8_STAGE(PG8_SA(1, 1), a1 + hstep, voffA);
            PG8_WAIT_L(8); PG8_BAR; PG8_WAIT_L(0); PG8_MMA(0, 0, At, B0); PG8_BAR; PG8_SCHED;
            PG8_LDB(B1, 0, 1); PG8_STAGE(PG8_SB(0, 0), b2, voffB);
            PG8_BAR; PG8_WAIT_L(0); PG8_MMA(0, 1, At, B1); PG8_BAR;
            PG8_LDA(At, 0, 1); PG8_STAGE(PG8_SA(0, 0), a2, voffA);
            PG8_BAR; PG8_WAIT_L(0); PG8_MMA(1, 0, At, B0); PG8_BAR; PG8_SCHED;
            PG8_STAGE(PG8_SB(0, 1), b2 + hstep, voffB);
            PG8_WAIT_V(6); PG8_BAR; PG8_MMA(1, 1, At, B1); PG8_BAR;
            PG8_LDB(B0, 1, 0); PG8_SCHED; PG8_LDA(At, 1, 0); PG8_STAGE(PG8_SA(0, 1), a2 + hstep, voffA);
            PG8_WAIT_L(8); PG8_BAR; PG8_WAIT_L(0); PG8_MMA(0, 0, At, B0); PG8_BAR; PG8_SCHED;
            PG8_LDB(B1, 1, 1); PG8_STAGE(PG8_SB(1, 0), b3, voffB);
            PG8_BAR; PG8_WAIT_L(0); PG8_MMA(0, 1, At, B1); PG8_BAR;
            PG8_LDA(At, 1, 1); PG8_STAGE(PG8_SA(1, 0), a3, voffA);
            PG8_BAR; PG8_WAIT_L(0); PG8_MMA(1, 0, At, B0); PG8_BAR; PG8_SCHED;
            PG8_STAGE(PG8_SB(1, 1), b3 + hstep, voffB);
            PG8_WAIT_V(6); PG8_BAR; PG8_MMA(1, 1, At, B1); PG8_BAR;
            }
        }
        if constexpr (ALIGN_EPI) { if (wr == 0) PG8_BAR; }
        if constexpr (!Epi::AFTER_DRAIN) { E(acc, cur, wr, wc, fr, fq); S.done(cur); }
        if (!has_next) break;
#pragma unroll
        for (int a = 0; a < 2; ++a)
#pragma unroll
            for (int b = 0; b < 2; ++b)
#pragma unroll
                for (int m = 0; m < 4; ++m)
#pragma unroll
                    for (int n = 0; n < 2; ++n) acc[a][b][m][n] = (f32x4){0.f, 0.f, 0.f, 0.f};
        cur = nxt; cA = nA; cB = nB; ++ui;
        if constexpr (ALIGN_EPI) { if (wr == 1) PG8_BAR; }
    }
    PG8_WAIT_V(0);
    if constexpr (!ALIGN_EPI) { if (wr == 0) PG8_BAR; }
    PG8_BAR;
    if constexpr (Epi::AFTER_DRAIN) { E.fused(acc, cur, wr, wc, fr, fq, lds, wid, lane); S.done(cur); }
#undef PG8_SA
#undef PG8_SB
#undef PG8_STAGE
#undef PG8_LDA
#undef PG8_LDB
#undef PG8_MMA
#undef PG8_WAIT_V
#undef PG8_WAIT_L
#undef PG8_BAR
#undef PG8_SCHED
}
}

#define LAS __attribute__((address_space(3)))
typedef unsigned short bf16;
typedef float f32x4 __attribute__((ext_vector_type(4)));
typedef float f32x2 __attribute__((ext_vector_type(2)));
typedef unsigned u32x4 __attribute__((ext_vector_type(4)));
typedef unsigned u32x2 __attribute__((ext_vector_type(2)));
typedef short bf16x8 __attribute__((ext_vector_type(8)));

constexpr int NB = 4, SEQ = 2048, DM = 2048, MT = NB * SEQ, NMOD = 6 * DM;
constexpr int NIN = 3904, NINP = 4096, QLR = 512, KVLR = 256, NQB = 1536, NKVB = 2048, DFF = 8192;
constexpr float EPS = 1e-6f, LOG2E = 1.4426950408889634f;
constexpr float QS_D = 0.125f * LOG2E;
constexpr float QS_M = 0.07216878364870322f * LOG2E;
constexpr float LAMBDA_INIT = 0.2f;

constexpr size_t MiB = 1u << 20;
constexpr size_t WS_CTL = 0, CTL_ZERO_BYTES = 1 * MiB;
constexpr size_t WS_MODP = 1 * MiB;
constexpr size_t WS_MOD = 7 * MiB;
constexpr size_t WS_ROPED = 8 * MiB;
constexpr size_t WS_ROPEM = 8 * MiB + 512 * 1024;
constexpr size_t WS_SSQQ = 11 * MiB;
constexpr size_t WS_SSQKV = 11 * MiB + 256 * 1024;
constexpr size_t WS_SSQ2 = 11 * MiB + 512 * 1024;
constexpr size_t WS_SSQ3 = 11 * MiB + 768 * 1024;
constexpr size_t WS_TB = 12 * MiB;
constexpr size_t WS_LAM = 12 * MiB + 512 * 1024;
constexpr size_t WS_WIN = 16 * MiB;
constexpr size_t WS_WQB = 32 * MiB;
constexpr size_t WS_WKVB = 34 * MiB;
constexpr size_t WS_WOUT = 36 * MiB;
constexpr size_t WS_W1 = 44 * MiB;
constexpr size_t WS_W2 = 76 * MiB;
constexpr size_t WS_MIX = 108 * MiB;
constexpr size_t WS_A2 = 140 * MiB;
constexpr size_t WS_H = 172 * MiB;
constexpr size_t WS_XN = 172 * MiB;
constexpr size_t WS_QD = 204 * MiB;
constexpr size_t WS_KD = 220 * MiB;
constexpr size_t WS_VD = 236 * MiB;
constexpr size_t WS_QLAT = 252 * MiB;
constexpr size_t WS_KVLAT = 260 * MiB;
constexpr size_t WS_QM = 264 * MiB;
constexpr size_t WS_KM = 300 * MiB;
constexpr size_t WS_VM = 324 * MiB;
constexpr size_t WS_OST = 340 * MiB;
constexpr size_t WS_END = 372 * MiB;

constexpr int LDS_BYTES = 147456;

struct Ctx {
    const float *x, *c; const int* pos; const float *w_ada, *b_ada, *g_mix, *w_in, *lq1, *lk1, *lq2, *lk2, *g_dsub, *g_qa, *w_qb, *g_kva, *w_kvb, *w_out, *g_ffn, *w_ff1, *w_ff2, *g_fin;
    float* out; unsigned char* ws;
};
#define WSP(T, off) ((T*)(c.ws + (off)))

__constant__ double INV_D[8] = {1.0, 0.19392274474868576, 0.03760603093086393, 0.007292664737217109, 0.001414213562373095, 0.0002742481756762073, 5.318295896944988e-05, 1.031338537721246e-05};
__constant__ double INV_M[32] = {1.0, 0.7498942093324559, 0.5623413251903491, 0.4216965034285822, 0.31622776601683794, 0.23713737056616552, 0.1778279410038923, 0.1333521432163324, 0.1, 0.07498942093324558, 0.05623413251903491, 0.042169650342858224, 0.03162277660168379, 0.023713737056616554, 0.01778279410038923, 0.01333521432163324, 0.01, 0.007498942093324558, 0.005623413251903491, 0.004216965034285823, 0.0031622776601683794, 0.0023713737056616554, 0.0017782794100389228, 0.001333521432163324, 0.001, 0.0007498942093324559, 0.0005623413251903491, 0.00042169650342858224, 0.00031622776601683794, 0.00023713737056616554, 0.00017782794100389227, 0.0001333521432163324};

#define LDS_WAIT() asm volatile("s_waitcnt lgkmcnt(0)" ::: "memory")
#define VM_WAIT() asm volatile("s_waitcnt vmcnt(0)" ::: "memory")
__device__ __forceinline__ int rfl(int v) { return __builtin_amdgcn_readfirstlane(v); }
__device__ __forceinline__ unsigned pk2(float lo, float hi) { return pg8::cvt_pk_bf16(lo, hi); }
__device__ __forceinline__ float bflo(unsigned w) { return __builtin_bit_cast(float, w << 16); }
__device__ __forceinline__ float bfhi(unsigned w) { return __builtin_bit_cast(float, w & 0xffff0000u); }
__device__ __forceinline__ float bf2f(bf16 h) { return __builtin_bit_cast(float, (unsigned)h << 16); }
__device__ __forceinline__ float wave_sum(float v) {
#pragma unroll
    for (int o = 1; o < 64; o <<= 1) v += __shfl_xor(v, o);
    return v;
}
__device__ __forceinline__ float wave_max(float v) {
#pragma unroll
    for (int o = 1; o < 64; o <<= 1) v = fmaxf(v, __shfl_xor(v, o));
    return v;
}
__device__ __forceinline__ float dot4(f32x4 a, f32x4 b) { return (a[0] * b[0] + a[1] * b[1]) + (a[2] * b[2] + a[3] * b[3]); }
__device__ __forceinline__ f32x4 rope4(f32x4 v, f32x4 cs) { return (f32x4){v[0] * cs[0] - v[1] * cs[1], v[1] * cs[0] + v[0] * cs[1], v[2] * cs[2] - v[3] * cs[3], v[3] * cs[2] + v[2] * cs[3]}; }
__device__ __forceinline__ void st_bf4(bf16* p, f32x4 v) { u32x2 w; w.x = pk2(v[0], v[1]); w.y = pk2(v[2], v[3]); *(u32x2*)p = w; }

__device__ __forceinline__ void adaln_job(const Ctx& c, int job, int lane) {
    const int cj = job % 48, ks = job / 48;
    const int n0 = cj * 256 + lane * 4, k0 = ks * 64;
    float sl[4];
#pragma unroll
    for (int b = 0; b < 4; ++b) { const float v = c.c[b * DM + k0 + lane]; sl[b] = v / (1.f + __expf(-v)); }
    f32x4 acc[4];
#pragma unroll
    for (int b = 0; b < 4; ++b) acc[b] = (f32x4){0.f, 0.f, 0.f, 0.f};
    const float* wp = c.w_ada + (size_t)k0 * NMOD + n0;
#pragma unroll 8
    for (int kk = 0; kk < 64; ++kk) {
        const f32x4 w = *(const f32x4*)(wp + (size_t)kk * NMOD);
#pragma unroll
        for (int b = 0; b < 4; ++b) { const float s = __shfl(sl[b], kk); acc[b] += w * s; }
    }
    float* modp = WSP(float, WS_MODP);
#pragma unroll
    for (int b = 0; b < 4; ++b) *(f32x4*)(modp + (size_t)(ks * 4 + b) * NMOD + n0) = acc[b];
}
template <int MAP> __device__ __forceinline__ int dst_row(int s) {
    if (MAP == 1) {
        if (s < 2048) { const int d = s & 63; const int j = d < 8 ? 2 * d : (d < 16 ? 2 * (d - 8) + 1 : d); return (s & ~63) | j; }
        if (s < 3840) return s;
        const int d = s - 3840; return 3840 + (d < 32 ? 2 * d : 2 * (d - 32) + 1);
    }
    if (MAP == 2) {
        const int h = s / 192, j = s - h * 192; if (j < 128) return s;
        const int d = j - 128; return h * 192 + 128 + (d < 32 ? 2 * d : 2 * (d - 32) + 1);
    }
    return s;
}
template <int MAP, int KSM> __device__ __forceinline__ void tr_item(const float* W, int K, int N, bf16* WT, const float* ks, LAS float* scr, int item, int lane) {
    const int nblk = N / 32, kb = item / nblk, nb = item - kb * nblk, k0 = 64 * kb, n0 = 32 * nb;
#pragma unroll 8
    for (int i = 0; i < 32; ++i) { const int kk = 2 * i + (lane >> 5); float v = W[(size_t)(k0 + kk) * N + n0 + (lane & 31)];
        if (KSM == 1) v *= ks[k0 + kk];
        if (KSM == 2) { const int k = k0 + kk; if (k < 1024) v *= ks[k & 127] * (1.f - LAMBDA_INIT); }
        scr[kk * 33 + (lane & 31)] = v; }
    LDS_WAIT(); asm volatile("" ::: "memory");
    const int cc = lane & 7;
#pragma unroll
    for (int j = 0; j < 4; ++j) { const int n = (lane >> 3) + 8 * j; const LAS float* s = scr + (8 * cc) * 33 + n;
        u32x4 o; o.x = pk2(s[0 * 33], s[1 * 33]); o.y = pk2(s[2 * 33], s[3 * 33]); o.z = pk2(s[4 * 33], s[5 * 33]); o.w = pk2(s[6 * 33], s[7 * 33]);
        *(u32x4*)(WT + (size_t)dst_row<MAP>(n0 + n) * K + k0 + 8 * cc) = o; }
    LDS_WAIT(); asm volatile("" ::: "memory");
}
__device__ __forceinline__ void sincos_d(double x, float& cs, float& sn) {
    const double q = __builtin_rint(x * 0.63661977236758134308);
    double r = __builtin_fma(-q, 1.57079632679489655800e+00, x); r = __builtin_fma(-q, 6.12323399573676603587e-17, r);
    const double r2 = r * r;
    const double s = r * (1.0 + r2 * (-1.0 / 6 + r2 * (1.0 / 120 + r2 * (-1.0 / 5040 + r2 * (1.0 / 362880 + r2 * (-1.0 / 39916800))))));
    const double co = 1.0 + r2 * (-0.5 + r2 * (1.0 / 24 + r2 * (-1.0 / 720 + r2 * (1.0 / 40320 + r2 * (-1.0 / 3628800 + r2 * (1.0 / 479001600))))));
    const int qi = (int)q & 3;
    double cc = (qi & 1) ? s : co, ss = (qi & 1) ? co : s;
    if (qi == 1 || qi == 2) cc = -cc;
    if (qi == 2 || qi == 3) ss = -ss;
    cs = (float)cc; sn = (float)ss;
}
__device__ __forceinline__ void rope_job(const Ctx& c, int job, int lane) {
    const int row = job * 64 + lane; const double p = (double)c.pos[row];
    f32x2* rd = WSP(f32x2, WS_ROPED) + (size_t)row * 8; f32x2* rm = WSP(f32x2, WS_ROPEM) + (size_t)row * 32;
    for (int i = 0; i < 8; ++i) { float cs, sn; sincos_d(p * INV_D[i], cs, sn); rd[i] = (f32x2){cs, sn}; }
    for (int i = 0; i < 32; ++i) { float cs, sn; sincos_d(p * INV_M[i], cs, sn); rm[i] = (f32x2){cs, sn}; }
}
__device__ __forceinline__ void phase_p0a(const Ctx& c, LAS unsigned char* lds) {
    const int tid = threadIdx.x, lane = tid & 63, wave = rfl(tid >> 6);
    const int gw = blockIdx.x * 8 + wave, NGW = gridDim.x * 8;
    LAS float* scr = (LAS float*)(lds + wave * 16384);
    constexpr int J_ADA = 48 * 32;
    constexpr int I_F1 = (DM / 64) * (DFF / 32), I_F2 = (DFF / 64) * (DM / 32), I_IN = (DM / 64) * (NIN / 32), I_OUT = (DM / 64) * (DM / 32), I_QB = (QLR / 64) * (NQB / 32), I_KVB = (KVLR / 64) * (NKVB / 32);
    constexpr int J_ROPE = MT / 64, J_PAD = NINP - NIN, J_LAM = 1;
    constexpr int TOTAL = J_ADA + I_F1 + I_F2 + I_IN + I_OUT + I_QB + I_KVB + J_ROPE + J_PAD + J_LAM;
    for (int it = gw; it < TOTAL; it += NGW) {
        int r = it;
        if (r < J_ADA) { adaln_job(c, r, lane); continue; } r -= J_ADA;
        if (r < I_F1) { tr_item<0, 0>(c.w_ff1, DM, DFF, WSP(bf16, WS_W1), nullptr, scr, r, lane); continue; } r -= I_F1;
        if (r < I_F2) { tr_item<0, 0>(c.w_ff2, DFF, DM, WSP(bf16, WS_W2), nullptr, scr, r, lane); continue; } r -= I_F2;
        if (r < I_IN) { tr_item<1, 0>(c.w_in, DM, NIN, WSP(bf16, WS_WIN), nullptr, scr, r, lane); continue; } r -= I_IN;
        if (r < I_OUT) { tr_item<0, 2>(c.w_out, DM, DM, WSP(bf16, WS_WOUT), c.g_dsub, scr, r, lane); continue; } r -= I_OUT;
        if (r < I_QB) { tr_item<2, 1>(c.w_qb, QLR, NQB, WSP(bf16, WS_WQB), c.g_qa, scr, r, lane); continue; } r -= I_QB;
        if (r < I_KVB) { tr_item<0, 1>(c.w_kvb, KVLR, NKVB, WSP(bf16, WS_WKVB), c.g_kva, scr, r, lane); continue; } r -= I_KVB;
        if (r < J_ROPE) { rope_job(c, r, lane); continue; } r -= J_ROPE;
        if (r < J_PAD) { u32x4* p = (u32x4*)(WSP(bf16, WS_WIN) + (size_t)(NIN + r) * DM);
#pragma unroll
            for (int j = 0; j < 4; ++j) p[lane + 64 * j] = (u32x4){0u, 0u, 0u, 0u};
            continue; } r -= J_PAD;
        {
            const float a = wave_sum(c.lq1[lane] * c.lk1[lane]), b = wave_sum(c.lq2[lane] * c.lk2[lane]);
            if (lane == 0) *WSP(float, WS_LAM) = __expf(a) - __expf(b) + LAMBDA_INIT;
        }
    }
}
__device__ __forceinline__ void phase_p0b(const Ctx& c) {
    const float* modp = WSP(float, WS_MODP); float* mod = WSP(float, WS_MOD);
    for (int i = blockIdx.x * 512 + threadIdx.x; i < 4 * NMOD; i += gridDim.x * 512) {
        const int n = i % NMOD, b = i / NMOD; float s = c.b_ada[n];
#pragma unroll 8
        for (int ks = 0; ks < 32; ++ks) s += modp[(size_t)(ks * 4 + b) * NMOD + n];
        mod[i] = s;
    }
}
__device__ __forceinline__ void phase_p0c(const Ctx& c, LAS unsigned char* lds) {
    const int tid = threadIdx.x, lane = tid & 63, wave = rfl(tid >> 6);
    const int gw = blockIdx.x * 8 + wave, NGW = gridDim.x * 8;
    const float* mod = WSP(float, WS_MOD);
    LAS float* shl = (LAS float*)lds;
    for (int i = tid; i < 4 * DM; i += 512) shl[i] = mod[(size_t)(i >> 11) * NMOD + 3 * DM + (i & 2047)];
    __syncthreads();
    const bf16* W1T = WSP(bf16, WS_W1); float* TB = WSP(float, WS_TB);
    for (int n = gw; n < DFF; n += NGW) {
        float acc[4] = {0.f, 0.f, 0.f, 0.f};
#pragma unroll
        for (int j2 = 0; j2 < 4; ++j2) { const int k = (j2 * 64 + lane) * 8; const u32x4 w = *(const u32x4*)(W1T + (size_t)n * DM + k);
            const f32x4 w0 = {bflo(w.x), bfhi(w.x), bflo(w.y), bfhi(w.y)}, w1 = {bflo(w.z), bfhi(w.z), bflo(w.w), bfhi(w.w)};
#pragma unroll
            for (int b = 0; b < 4; ++b) { const f32x4 s0 = *(const LAS f32x4*)(shl + b * DM + k), s1 = *(const LAS f32x4*)(shl + b * DM + k + 4); acc[b] += dot4(w0, s0) + dot4(w1, s1); } }
#pragma unroll
        for (int b = 0; b < 4; ++b) { const float t = wave_sum(acc[b]); if (lane == 0) TB[b * DFF + n] = t; }
    }
    bf16* XN = WSP(bf16, WS_XN);
    for (int row = gw; row < MT; row += NGW) {
        const int b = row >> 11; const f32x4* xr = (const f32x4*)(c.x + (size_t)row * DM) + lane;
        f32x4 v[8]; float ss = 0.f;
#pragma unroll
        for (int j = 0; j < 8; ++j) { v[j] = xr[64 * j]; ss += dot4(v[j], v[j]); }
        const float rstd = 1.0f / sqrtf(wave_sum(ss) * (1.f / DM) + EPS);
#pragma unroll
        for (int j = 0; j < 8; ++j) { const int col = 4 * lane + 256 * j;
            const f32x4 g = *(const f32x4*)(c.g_mix + col), sc = *(const f32x4*)(mod + (size_t)b * NMOD + DM + col), sh = *(const f32x4*)(mod + (size_t)b * NMOD + col);
            st_bf4(XN + (size_t)row * DM + col, v[j] * rstd * g * (1.f + sc) + sh); }
    }
}

struct EpiIn {
    static constexpr bool PERM = false, AFTER_DRAIN = false;
    Ctx c;
    __device__ __forceinline__ void operator()(const pg8::f32x4 (&acc)[2][2][4][2], const pg8::Unit& u, int wr, int wc, int fr, int fq) const {
        const int pn = u.pn; const f32x4* ropeD = (const f32x4*)WSP(f32x2, WS_ROPED); const f32x4* ropeM = (const f32x4*)WSP(f32x2, WS_ROPEM);
#pragma unroll
        for (int ai = 0; ai < 2; ++ai)
#pragma unroll
            for (int m = 0; m < 4; ++m) {
                const int row = u.pm * 256 + ai * 128 + wr * 64 + m * 16 + fr;
                if (pn < 8) {
                    bf16* dst = (pn < 4 ? WSP(bf16, WS_QD) : WSP(bf16, WS_KD)) + (size_t)row * 1024 + (pn & 3) * 256 + wc * 32 + 4 * fq;
                    const float sc = pn < 4 ? QS_D : 1.f;
                    const bool rp = (wc & 1) == 0;
                    f32x4 cs = {1.f, 0.f, 1.f, 0.f}; if (rp) cs = ropeD[(size_t)row * 4 + fq];
#pragma unroll
                    for (int bj = 0; bj < 2; ++bj)
#pragma unroll
                        for (int n = 0; n < 2; ++n) { f32x4 v = acc[ai][bj][m][n]; if (n == 0 && rp) v = rope4(v, cs); st_bf4(dst + bj * 128 + n * 16, v * sc); }
                } else if (pn < 12) {
                    bf16* dst = WSP(bf16, WS_VD) + (size_t)row * 1024 + (pn - 8) * 256 + wc * 32 + 4 * fq;
#pragma unroll
                    for (int bj = 0; bj < 2; ++bj)
#pragma unroll
                        for (int n = 0; n < 2; ++n) st_bf4(dst + bj * 128 + n * 16, acc[ai][bj][m][n]);
                } else if (pn < 15) {
                    bf16* dst = pn < 14 ? WSP(bf16, WS_QLAT) + (size_t)row * QLR + (pn - 12) * 256 + wc * 32 + 4 * fq : WSP(bf16, WS_KVLAT) + (size_t)row * KVLR + wc * 32 + 4 * fq;
                    float s = 0.f;
#pragma unroll
                    for (int bj = 0; bj < 2; ++bj)
#pragma unroll
                        for (int n = 0; n < 2; ++n) { const f32x4 v = acc[ai][bj][m][n]; s += dot4(v, v); st_bf4(dst + bj * 128 + n * 16, v); }
                    s += __shfl_xor(s, 16); s += __shfl_xor(s, 32);
                    if (fq == 0) { if (pn < 14) WSP(float, WS_SSQQ)[(size_t)row * 8 + (pn - 12) * 4 + wc] = s; else WSP(float, WS_SSQKV)[(size_t)row * 4 + wc] = s; }
                } else {
                    if (wc < 2) {
                        bf16* dst = WSP(bf16, WS_KM) + (size_t)row * NQB + 128 + wc * 32 + 4 * fq;
#pragma unroll
                        for (int n = 0; n < 2; ++n) { const int cc = wc * 32 + n * 16 + 4 * fq; const f32x4 cs = ropeM[(size_t)row * 16 + (cc >> 2)];
                            const f32x4 v = rope4(acc[ai][0][m][n], cs);
#pragma unroll
                            for (int h = 0; h < 8; ++h) st_bf4(dst + h * 192 + n * 16, v); }
                    }
                }
            }
    }
};
struct EpiQB {
    static constexpr bool PERM = false, AFTER_DRAIN = false;
    Ctx c;
    __device__ __forceinline__ void operator()(const pg8::f32x4 (&acc)[2][2][4][2], const pg8::Unit& u, int wr, int wc, int fr, int fq) const {
        const f32x4* ropeM = (const f32x4*)WSP(f32x2, WS_ROPEM); const f32x4* ssq = (const f32x4*)WSP(float, WS_SSQQ);
#pragma unroll
        for (int ai = 0; ai < 2; ++ai)
#pragma unroll
            for (int m = 0; m < 4; ++m) {
                const int row = u.pm * 256 + ai * 128 + wr * 64 + m * 16 + fr;
                const f32x4 s0 = ssq[(size_t)row * 2], s1 = ssq[(size_t)row * 2 + 1];
                const float rstd = QS_M / sqrtf(((s0[0] + s0[1]) + (s0[2] + s0[3]) + (s1[0] + s1[1]) + (s1[2] + s1[3])) * (1.f / QLR) + EPS);
#pragma unroll
                for (int bj = 0; bj < 2; ++bj)
#pragma unroll
                    for (int n = 0; n < 2; ++n) { const int col = u.pn * 256 + bj * 128 + wc * 32 + n * 16 + 4 * fq; const int h = col / 192, j = col - h * 192;
                        f32x4 v = acc[ai][bj][m][n] * rstd;
                        if (j >= 128) v = rope4(v, ropeM[(size_t)row * 16 + ((j - 128) >> 2)]);
                        st_bf4(WSP(bf16, WS_QM) + (size_t)row * NQB + col, v); }
            }
    }
};
struct EpiKVB {
    static constexpr bool PERM = false, AFTER_DRAIN = false;
    Ctx c;
    __device__ __forceinline__ void operator()(const pg8::f32x4 (&acc)[2][2][4][2], const pg8::Unit& u, int wr, int wc, int fr, int fq) const {
        const f32x4* ssq = (const f32x4*)WSP(float, WS_SSQKV);
        const int h = u.pn;
#pragma unroll
        for (int ai = 0; ai < 2; ++ai)
#pragma unroll
            for (int m = 0; m < 4; ++m) {
                const int row = u.pm * 256 + ai * 128 + wr * 64 + m * 16 + fr;
                const f32x4 s0 = ssq[row];
                const float rstd = 1.0f / sqrtf(((s0[0] + s0[1]) + (s0[2] + s0[3])) * (1.f / KVLR) + EPS);
#pragma unroll
                for (int n = 0; n < 2; ++n) { const int j = wc * 32 + n * 16 + 4 * fq;
                    st_bf4(WSP(bf16, WS_KM) + (size_t)row * NQB + h * 192 + j, acc[ai][0][m][n] * rstd);
                    st_bf4(WSP(bf16, WS_VM) + (size_t)row * 1024 + h * 128 + j, acc[ai][1][m][n] * rstd); }
            }
    }
};
__device__ __forceinline__ void tile_ssq_publish(PG8_LAS unsigned char* lds, float* slots, const pg8::Unit& u) {
    asm volatile("s_waitcnt lgkmcnt(0)" ::: "memory"); __builtin_amdgcn_s_barrier(); asm volatile("" ::: "memory");
    const int t = threadIdx.x;
    if (t < 256) { const f32x4 p = *(const PG8_LAS f32x4*)(lds + t * 16); slots[(size_t)(u.pm * 256 + t) * 8 + u.pn] = (p[0] + p[1]) + (p[2] + p[3]); }
}
struct EpiOut {
    static constexpr bool PERM = false, AFTER_DRAIN = true;
    Ctx c;
    __device__ __forceinline__ void fused(pg8::f32x4 (&acc)[2][2][4][2], const pg8::Unit& u, int wr, int wc, int fr, int fq, PG8_LAS unsigned char* lds, int wid, int lane) const {
        PG8_LAS float* P = (PG8_LAS float*)lds; const float* mod = WSP(float, WS_MOD);
        const int col0 = u.pn * 256 + wc * 32 + 4 * fq;
#pragma unroll
        for (int ai = 0; ai < 2; ++ai)
#pragma unroll
            for (int m = 0; m < 4; ++m) {
                const int rt = ai * 128 + wr * 64 + m * 16 + fr, row = u.pm * 256 + rt, b = row >> 11; float s = 0.f;
#pragma unroll
                for (int bj = 0; bj < 2; ++bj)
#pragma unroll
                    for (int n = 0; n < 2; ++n) { const int col = col0 + bj * 128 + n * 16; const size_t off = (size_t)row * DM + col;
                        const f32x4 gate = *(const f32x4*)(mod + (size_t)b * NMOD + 2 * DM + col), xv = *(const f32x4*)(c.x + off);
                        const f32x4 v = xv + gate * acc[ai][bj][m][n];
                        *(f32x4*)(c.out + off) = v; s += dot4(v, v);
                        const f32x4 gs = *(const f32x4*)(c.g_ffn + col) * (1.f + *(const f32x4*)(mod + (size_t)b * NMOD + 4 * DM + col));
                        st_bf4(WSP(bf16, WS_A2) + off, v * gs); }
                s += __shfl_xor(s, 16); s += __shfl_xor(s, 32);
                if (fq == 0) P[rt * 4 + wc] = s;
            }
        tile_ssq_publish(lds, WSP(float, WS_SSQ2), u);
    }
};
struct EpiF1 {
    static constexpr bool PERM = false, AFTER_DRAIN = false;
    Ctx c;
    __device__ __forceinline__ void operator()(const pg8::f32x4 (&acc)[2][2][4][2], const pg8::Unit& u, int wr, int wc, int fr, int fq) const {
        const f32x4* ssq = (const f32x4*)WSP(float, WS_SSQ2); const float* TB = WSP(float, WS_TB);
        const int col0 = u.pn * 256 + wc * 32 + 4 * fq, b = (u.pm * 256) >> 11;
        f32x4 tb[2][2];
#pragma unroll
        for (int bj = 0; bj < 2; ++bj)
#pragma unroll
            for (int n = 0; n < 2; ++n) tb[bj][n] = *(const f32x4*)(TB + (size_t)b * DFF + col0 + bj * 128 + n * 16);
#pragma unroll
        for (int ai = 0; ai < 2; ++ai)
#pragma unroll
            for (int m = 0; m < 4; ++m) {
                const int row = u.pm * 256 + ai * 128 + wr * 64 + m * 16 + fr;
                const f32x4 s0 = ssq[(size_t)row * 2], s1 = ssq[(size_t)row * 2 + 1];
                const float rstd = 1.0f / sqrtf(((s0[0] + s0[1]) + (s0[2] + s0[3]) + (s1[0] + s1[1]) + (s1[2] + s1[3])) * (1.f / DM) + EPS);
#pragma unroll
                for (int bj = 0; bj < 2; ++bj)
#pragma unroll
                    for (int n = 0; n < 2; ++n) { f32x4 v = acc[ai][bj][m][n] * rstd + tb[bj][n];
                        v = __builtin_elementwise_max(v, (f32x4){0.f, 0.f, 0.f, 0.f}); v = v * v;
                        st_bf4(WSP(bf16, WS_H) + (size_t)row * DFF + col0 + bj * 128 + n * 16, v); }
            }
    }
};
struct EpiF2 {
    static constexpr bool PERM = false, AFTER_DRAIN = true;
    Ctx c;
    __device__ __forceinline__ void fused(pg8::f32x4 (&acc)[2][2][4][2], const pg8::Unit& u, int wr, int wc, int fr, int fq, PG8_LAS unsigned char* lds, int wid, int lane) const {
        PG8_LAS float* P = (PG8_LAS float*)lds; const float* mod = WSP(float, WS_MOD);
        const int col0 = u.pn * 256 + wc * 32 + 4 * fq;
#pragma unroll
        for (int ai = 0; ai < 2; ++ai)
#pragma unroll
            for (int m = 0; m < 4; ++m) {
                const int rt = ai * 128 + wr * 64 + m * 16 + fr, row = u.pm * 256 + rt, b = row >> 11; float s = 0.f;
#pragma unroll
                for (int bj = 0; bj < 2; ++bj)
#pragma unroll
                    for (int n = 0; n < 2; ++n) { const int col = col0 + bj * 128 + n * 16; const size_t off = (size_t)row * DM + col;
                        const f32x4 gate = *(const f32x4*)(mod + (size_t)b * NMOD + 5 * DM + col), xv = *(const f32x4*)(c.out + off);
                        const f32x4 v = xv + gate * acc[ai][bj][m][n];
                        *(f32x4*)(c.out + off) = v; s += dot4(v, v); }
                s += __shfl_xor(s, 16); s += __shfl_xor(s, 32);
                if (fq == 0) P[rt * 4 + wc] = s;
            }
        tile_ssq_publish(lds, WSP(float, WS_SSQ3), u);
    }
};

template <class Epi> __device__ __forceinline__ void run_gemm(LAS unsigned char* lds, const bf16* A, const bf16* Bt, int M, int N, int K, const Epi& E) {
    pg8::Gemm g{A, Bt, M, N, K}; pg8::StaticOrder S; S.init(M, N, (int)gridDim.x, (int)blockIdx.x);
    pg8::gemm_phase<Epi, pg8::StaticOrder, !Epi::AFTER_DRAIN, true>(lds, g, S, E);
}

template <int DQK> __device__ __forceinline__ void naive_attn_head(const bf16* q, const bf16* K, int ldk, const bf16* V, int ldv, LAS float* qf, LAS float* pl, int lane, float (&o)[2]) {
    for (int d = lane; d < DQK; d += 64) qf[d] = bf2f(q[d]);
    LDS_WAIT(); asm volatile("" ::: "memory");
    float mx = -1e30f;
    for (int t = 0; t < 32; ++t) { const bf16* kr = K + (size_t)(t * 64 + lane) * ldk; float a = 0.f;
#pragma unroll
        for (int d = 0; d < DQK; d += 8) { const u32x4 w = *(const u32x4*)(kr + d); const f32x4 q0 = *(const LAS f32x4*)(qf + d), q1 = *(const LAS f32x4*)(qf + d + 4);
            a += dot4((f32x4){bflo(w.x), bfhi(w.x), bflo(w.y), bfhi(w.y)}, q0) + dot4((f32x4){bflo(w.z), bfhi(w.z), bflo(w.w), bfhi(w.w)}, q1); }
        pl[t * 64 + lane] = a; mx = fmaxf(mx, a); }
    mx = wave_max(mx); float l = 0.f;
    LDS_WAIT(); asm volatile("" ::: "memory");
    for (int t = 0; t < 32; ++t) { const float p = __builtin_amdgcn_exp2f(pl[t * 64 + lane] - mx); l += p; pl[t * 64 + lane] = p; }
    l = wave_sum(l);
    LDS_WAIT(); asm volatile("" ::: "memory");
    float a0 = 0.f, a1 = 0.f;
#pragma unroll 8
    for (int k = 0; k < SEQ; ++k) { const unsigned w = *(const unsigned*)(V + (size_t)k * ldv + 2 * lane); const float p = pl[k]; a0 += p * bflo(w); a1 += p * bfhi(w); }
    const float il = 1.f / l; o[0] = a0 * il; o[1] = a1 * il;
    LDS_WAIT(); asm volatile("" ::: "memory");
}
__device__ __forceinline__ void phase_attn_naive(const Ctx& c, LAS unsigned char* lds) {
    const int tid = threadIdx.x, lane = tid & 63, wave = rfl(tid >> 6);
    const int gw = blockIdx.x * 8 + wave, NGW = gridDim.x * 8;
    LAS float* qf = (LAS float*)(lds + wave * 16384); LAS float* pl = qf + 256;
    const float lam = __builtin_bit_cast(float, __hip_atomic_load(WSP(unsigned, WS_LAM), __ATOMIC_RELAXED, __HIP_MEMORY_SCOPE_AGENT));
    bf16* MIX = WSP(bf16, WS_MIX);
    for (int job = gw; job < 2 * MT * 8; job += NGW) {
        const int type = job / (MT * 8), rh = job - type * (MT * 8), row = rh >> 3, h = rh & 7, kb = row & ~(SEQ - 1);
        if (type == 0) {
            float o1[2], o2[2];
            naive_attn_head<64>(WSP(bf16, WS_QD) + (size_t)row * 1024 + h * 128, WSP(bf16, WS_KD) + (size_t)kb * 1024 + h * 128, 1024, WSP(bf16, WS_VD) + (size_t)kb * 1024 + h * 128, 1024, qf, pl, lane, o1);
            naive_attn_head<64>(WSP(bf16, WS_QD) + (size_t)row * 1024 + h * 128 + 64, WSP(bf16, WS_KD) + (size_t)kb * 1024 + h * 128 + 64, 1024, WSP(bf16, WS_VD) + (size_t)kb * 1024 + h * 128, 1024, qf, pl, lane, o2);
            const float a = o1[0] - lam * o2[0], b = o1[1] - lam * o2[1];
            const float rstd = 1.0f / sqrtf(wave_sum(a * a + b * b) * (1.f / 128.f) + EPS);
            *(unsigned*)(MIX + (size_t)row * DM + h * 128 + 2 * lane) = pk2(a * rstd, b * rstd);
        } else {
            float o[2];
            naive_attn_head<192>(WSP(bf16, WS_QM) + (size_t)row * NQB + h * 192, WSP(bf16, WS_KM) + (size_t)kb * NQB + h * 192, NQB, WSP(bf16, WS_VM) + (size_t)kb * 1024 + h * 128, 1024, qf, pl, lane, o);
            *(unsigned*)(MIX + (size_t)row * DM + 1024 + h * 128 + 2 * lane) = pk2(o[0], o[1]);
        }
    }
}
__device__ __forceinline__ void phase_final(const Ctx& c) {
    const int tid = threadIdx.x, lane = tid & 63, wave = rfl(tid >> 6);
    const int gw = blockIdx.x * 8 + wave, NGW = gridDim.x * 8;
    const f32x4* ssq = (const f32x4*)WSP(float, WS_SSQ3);
    for (int row = gw; row < MT; row += NGW) {
        const f32x4 s0 = ssq[(size_t)row * 2], s1 = ssq[(size_t)row * 2 + 1];
        const float rstd = 1.0f / sqrtf(((s0[0] + s0[1]) + (s0[2] + s0[3]) + (s1[0] + s1[1]) + (s1[2] + s1[3])) * (1.f / DM) + EPS);
        f32x4* xr = (f32x4*)(c.out + (size_t)row * DM) + lane;
#pragma unroll
        for (int j = 0; j < 8; ++j) { const f32x4 g = *(const f32x4*)(c.g_fin + 4 * lane + 256 * j); xr[64 * j] = xr[64 * j] * rstd * g; }
    }
}


constexpr int CW_BAR = 4096;
constexpr int MISC_OFF = 131072 + 384;
#define XB_TMO      128
#define XB_XCNT(j)  (256  + 64 * (j))
#define XB_XSUB(j)  (1280 + 64 * (j))
#define XB_XGEN(j)  (2304 + 64 * (j))
#define XB_TOP      3328
#define XB_TOPGEN   3392
#define XCD_BAR_WORDS 3456
#define XB_SPIN_CAP (1u << 18)

__device__ __forceinline__ unsigned xb_ld(unsigned* p)              { return __hip_atomic_load(p, __ATOMIC_RELAXED, __HIP_MEMORY_SCOPE_AGENT); }
__device__ __forceinline__ unsigned xb_add(unsigned* p, unsigned v) { return __hip_atomic_fetch_add(p, v, __ATOMIC_RELAXED, __HIP_MEMORY_SCOPE_AGENT); }
__device__ __forceinline__ unsigned xb_xcc_id() { return (unsigned)__builtin_amdgcn_s_getreg((3 << 11) | 20) & 0xFu; }
#define XB_SPIN(cond, bar) do { unsigned _sp = 0; while (cond) { __builtin_amdgcn_s_sleep(1); \
    if ((++_sp & 255u) == 0u) { if (xb_ld(&(bar)[XB_TMO])) break; if (_sp > XB_SPIN_CAP) { atomicAdd(&(bar)[XB_TMO], 1u); break; } } } } while (0)

struct XcdBarrier {
    unsigned* bar; unsigned x;
    volatile LAS unsigned* st;
};

__device__ __forceinline__ XcdBarrier xcd_barrier_post(unsigned* bar, volatile LAS unsigned* st) {
    XcdBarrier b; b.bar = bar; b.x = xb_xcc_id(); b.st = st;
    if (threadIdx.x == 0) (void)xb_add(&bar[XB_XCNT(b.x)], 1u);
    return b;
}
__device__ __forceinline__ void xcd_barrier_complete(unsigned* bar, unsigned x, unsigned& nloc, unsigned& nx) {
    const unsigned G = gridDim.x * gridDim.y * gridDim.z;
    unsigned sum, cnt, mine, sp = 0u;
    for (;;) {
        sum = 0u; cnt = 0u; mine = 0u;
#pragma unroll
        for (unsigned j = 0; j < 16; ++j) { const unsigned c = xb_ld(&bar[XB_XCNT(j)]); sum += c; cnt += (c > 0u) ? 1u : 0u; mine = (j == x) ? c : mine; }
        if (sum == G) break;
        __builtin_amdgcn_s_sleep(1);
        if ((++sp & 255u) == 0u) { if (xb_ld(&bar[XB_TMO])) break; if (sp > XB_SPIN_CAP) { atomicAdd(&bar[XB_TMO], 1u); break; } }
    }
    nloc = mine > 0u ? mine : 1u; nx = cnt > 0u ? cnt : 1u;
}

__device__ __forceinline__ void xcd_barrier(const XcdBarrier& b) {
    asm volatile("s_waitcnt vmcnt(0)" ::: "memory");
    __syncthreads();
    if (threadIdx.x == 0) {
        unsigned* bar = b.bar;
        __builtin_amdgcn_s_waitcnt(0);
        unsigned nloc = b.st[0], nx = b.st[1];
        if (nloc == 0u) { xcd_barrier_complete(bar, b.x, nloc, nx); b.st[0] = nloc; b.st[1] = nx; }
        const unsigned old = xb_add(&bar[XB_XSUB(b.x)], 1u);
        const unsigned gen = old / nloc;
        if (old + 1u == (gen + 1u) * nloc) {
            __builtin_amdgcn_fence(__ATOMIC_RELEASE, "agent");
            asm volatile("s_waitcnt vmcnt(0)" ::: "memory");
            const unsigned og = xb_add(&bar[XB_TOP], 1u);
            const unsigned tg = og / nx;
            if (og + 1u == (tg + 1u) * nx) xb_add(&bar[XB_TOPGEN], 1u);
            else XB_SPIN(xb_ld(&bar[XB_TOPGEN]) == tg, bar);
            __builtin_amdgcn_fence(__ATOMIC_ACQUIRE, "agent");
            xb_add(&bar[XB_XGEN(b.x)], 1u);
            asm volatile("s_waitcnt vmcnt(0)" ::: "memory");
        } else {
            XB_SPIN(xb_ld(&bar[XB_XGEN(b.x)]) == gen, bar);
            __builtin_amdgcn_fence(__ATOMIC_ACQUIRE, "agent");
            asm volatile("s_waitcnt vmcnt(0)" ::: "memory");
        }
    }
    __syncthreads();
}


#ifndef MK_LAUNCHES
#define MK_LAUNCHES 1
#endif
#define KERNEL_HEAD extern __shared__ __attribute__((aligned(16))) unsigned char lds_raw[]; LAS unsigned char* lds = (LAS unsigned char*)lds_raw;
template <int PH> __device__ __forceinline__ void run_phase(const Ctx& c, LAS unsigned char* lds) {
    if (PH == 0) phase_p0a(c, lds);
    if (PH == 1) phase_p0b(c);
    if (PH == 2) phase_p0c(c, lds);
    if (PH == 3) { EpiIn E{c}; run_gemm(lds, WSP(bf16, WS_XN), WSP(bf16, WS_WIN), MT, NINP, DM, E); }
    if (PH == 4) { EpiQB E{c}; run_gemm(lds, WSP(bf16, WS_QLAT), WSP(bf16, WS_WQB), MT, NQB, QLR, E); }
    if (PH == 5) { EpiKVB E{c}; run_gemm(lds, WSP(bf16, WS_KVLAT), WSP(bf16, WS_WKVB), MT, NKVB, KVLR, E); }
    if (PH == 6) phase_attn_naive(c, lds);
    if (PH == 7) { EpiOut E{c}; run_gemm(lds, WSP(bf16, WS_MIX), WSP(bf16, WS_WOUT), MT, DM, DM, E); }
    if (PH == 8) { EpiF1 E{c}; run_gemm(lds, WSP(bf16, WS_A2), WSP(bf16, WS_W1), MT, DFF, DM, E); }
    if (PH == 9) { EpiF2 E{c}; run_gemm(lds, WSP(bf16, WS_H), WSP(bf16, WS_W2), MT, DM, DFF, E); }
    if (PH == 10) phase_final(c);
}
#if MK_LAUNCHES == 1
__global__ void __launch_bounds__(512, 2) mk_fwd(Ctx c) {
    KERNEL_HEAD
    volatile LAS unsigned* misc = (volatile LAS unsigned*)(lds + MISC_OFF);
    if (threadIdx.x < 4) misc[threadIdx.x] = 0u;
    __syncthreads();
    XcdBarrier bar = xcd_barrier_post((unsigned*)(c.ws + WS_CTL) + CW_BAR, misc);
    run_phase<0>(c, lds); xcd_barrier(bar);
    run_phase<1>(c, lds); xcd_barrier(bar);
    run_phase<2>(c, lds); xcd_barrier(bar);
    run_phase<3>(c, lds); xcd_barrier(bar);
    run_phase<4>(c, lds); run_phase<5>(c, lds); xcd_barrier(bar);
    run_phase<6>(c, lds); xcd_barrier(bar);
    run_phase<7>(c, lds); xcd_barrier(bar);
    run_phase<8>(c, lds); xcd_barrier(bar);
    run_phase<9>(c, lds); xcd_barrier(bar);
    run_phase<10>(c, lds);
}
#else
template <int PH> __global__ void __launch_bounds__(512, 2) k_phase(Ctx c) { KERNEL_HEAD run_phase<PH>(c, lds); }
#endif

extern "C" void kernel_launch(void* const* d_in, const int* in_sizes, int n_in, void* d_out, int out_size, void* d_ws, size_t ws_size, hipStream_t stream) {
    static int ok = 0;
    if (ok == 0) {
        if (n_in != 21 || in_sizes[0] != MT * DM || out_size != MT * DM || ws_size < WS_END) { fprintf(stderr, "kernel_launch: unexpected shapes: n_in %d in0 %d out %d ws %zu (need >= %zu)\n", n_in, n_in > 0 ? in_sizes[0] : -1, out_size, ws_size, (size_t)WS_END); ok = -1; return; }
#if MK_LAUNCHES == 1
        int dev = 0, cus = 0;
        if (hipGetDevice(&dev) != hipSuccess || hipDeviceGetAttribute(&cus, hipDeviceAttributeMultiprocessorCount, dev) != hipSuccess || cus < 256) { fprintf(stderr, "kernel_launch: needs a 256-CU device (one resident workgroup per CU), found %d\n", cus); ok = -1; return; }
        if (hipFuncSetAttribute((const void*)mk_fwd, hipFuncAttributeMaxDynamicSharedMemorySize, LDS_BYTES) != hipSuccess) { fprintf(stderr, "kernel_launch: hipFuncSetAttribute failed\n"); ok = -1; return; }
#else
        const void* ks[] = {(const void*)k_phase<0>, (const void*)k_phase<1>, (const void*)k_phase<2>, (const void*)k_phase<3>, (const void*)k_phase<4>, (const void*)k_phase<5>, (const void*)k_phase<6>, (const void*)k_phase<7>, (const void*)k_phase<8>, (const void*)k_phase<9>, (const void*)k_phase<10>};
        for (const void* k : ks) if (hipFuncSetAttribute(k, hipFuncAttributeMaxDynamicSharedMemorySize, LDS_BYTES) != hipSuccess) { fprintf(stderr, "kernel_launch: hipFuncSetAttribute failed\n"); ok = -1; return; }
#endif
        ok = 1;
    }
    if (ok < 0) return;
    Ctx c{};
    c.x = (const float*)d_in[0]; c.c = (const float*)d_in[1]; c.pos = (const int*)d_in[2]; c.w_ada = (const float*)d_in[3]; c.b_ada = (const float*)d_in[4]; c.g_mix = (const float*)d_in[5];
    c.w_in = (const float*)d_in[6]; c.lq1 = (const float*)d_in[7]; c.lk1 = (const float*)d_in[8]; c.lq2 = (const float*)d_in[9]; c.lk2 = (const float*)d_in[10]; c.g_dsub = (const float*)d_in[11];
    c.g_qa = (const float*)d_in[12]; c.w_qb = (const float*)d_in[13]; c.g_kva = (const float*)d_in[14]; c.w_kvb = (const float*)d_in[15]; c.w_out = (const float*)d_in[16]; c.g_ffn = (const float*)d_in[17];
    c.w_ff1 = (const float*)d_in[18]; c.w_ff2 = (const float*)d_in[19]; c.g_fin = (const float*)d_in[20]; c.out = (float*)d_out; c.ws = (unsigned char*)d_ws;
    const dim3 grid(256), block(512);
#if MK_LAUNCHES == 1
    if (hipMemsetAsync((char*)d_ws + WS_CTL, 0, 65536, stream) != hipSuccess) { fprintf(stderr, "kernel_launch: hipMemsetAsync failed\n"); return; }
    hipLaunchKernelGGL(mk_fwd, grid, block, LDS_BYTES, stream, c);
#else
    hipLaunchKernelGGL(k_phase<0>, grid, block, LDS_BYTES, stream, c); hipLaunchKernelGGL(k_phase<1>, grid, block, LDS_BYTES, stream, c); hipLaunchKernelGGL(k_phase<2>, grid, block, LDS_BYTES, stream, c);
    hipLaunchKernelGGL(k_phase<3>, grid, block, LDS_BYTES, stream, c); hipLaunchKernelGGL(k_phase<4>, grid, block, LDS_BYTES, stream, c); hipLaunchKernelGGL(k_phase<5>, grid, block, LDS_BYTES, stream, c);
    hipLaunchKernelGGL(k_phase<6>, grid, block, LDS_BYTES, stream, c); hipLaunchKernelGGL(k_phase<7>, grid, block, LDS_BYTES, stream, c); hipLaunchKernelGGL(k_phase<8>, grid, block, LDS_BYTES, stream, c);
    hipLaunchKernelGGL(k_phase<9>, grid, block, LDS_BYTES, stream, c); hipLaunchKernelGGL(k_phase<10>, grid, block, LDS_BYTES, stream, c);
#endif
    const hipError_t le = hipPeekAtLastError();
    if (le != hipSuccess) fprintf(stderr, "kernel_launch: launch failed: %s\n", hipGetErrorName(le));
}
```

```cpp
#include <hip/hip_runtime.h>
#include <cstdio>
#include <cstdint>

namespace pg8 {
#define PG8_LAS __attribute__((address_space(3)))
typedef unsigned short bf16_t;
typedef short bf16x8 __attribute__((ext_vector_type(8)));
typedef float f32x4 __attribute__((ext_vector_type(4)));
typedef unsigned u32x4 __attribute__((ext_vector_type(4)));
constexpr int BM = 256, BK = 64, HALF = 128, HTB = HALF * BK * 2  , STAGE_BYTES = 8 * HTB, NXCD = 8, WGM = 8;

__host__ __device__ __forceinline__ int lds_byte(int r, int c) { const int st = (r >> 4) * 2 + (c >> 5), rr = r & 15, cc = c & 31, ob = rr * 64 + cc * 2; return st * 1024 + (ob ^ (((ob >> 9) & 1) << 5)); }
__host__ __device__ __forceinline__ void stage_rc(int b, int& R, int& C) { const int st = b / 1024, sb = b % 1024, swz = sb ^ (((sb >> 9) & 1) << 5); R = (st >> 1) * 16 + swz / 64; C = (st & 1) * 32 + (swz % 64) / 2; }
__host__ __device__ __forceinline__ int perm32(int rho) { const int n = rho >> 4, i = rho & 15; return 8 * (i >> 2) + 4 * n + (i & 3); }

struct Unit { int pm, pn; };
struct Gemm { const bf16_t* A; const bf16_t* Bt; int M, N, K; };

struct StaticOrder {
    int nM, nN, nwg, G, c;
    __host__ __device__ void init(int M, int N, int G_, int c_) { nM = M / BM; nN = N / BM; nwg = nM * nN; G = G_; c = c_; }
    __host__ __device__ bool next(int i, Unit& u) const {
        const long L = (long)i * G + c; if (L >= nwg) return false;
        int wgid = (int)L; { const int q = nwg / NXCD, r = nwg % NXCD, xcd = wgid % NXCD, off = wgid / NXCD; wgid = (xcd < r ? xcd * (q + 1) : r * (q + 1) + (xcd - r) * q) + off; }
        const int nig = WGM * nN, gid = wgid / nig, fm = gid * WGM, gsz = (nM - fm) < WGM ? (nM - fm) : WGM;
        u.pm = fm + ((wgid % nig) % gsz); u.pn = (wgid % nig) / gsz; return true;
    }
    __device__ __forceinline__ void a_ready(const Unit&) const {}
    __device__ __forceinline__ void done(const Unit&) const {}
};
__device__ __forceinline__ unsigned cvt_pk_bf16(float lo, float hi) { unsigned r; asm volatile("v_cvt_pk_bf16_f32 %0, %1, %2" : "=v"(r) : "v"(lo), "v"(hi)); return r; }
typedef float f32x2 __attribute__((ext_vector_type(2)));
template <class Epi, class Sched, bool ALIGN_EPI = false, bool SP2 = false>
__device__ __forceinline__ void gemm_phase(PG8_LAS unsigned char* lds, const Gemm g, const Sched& S, const Epi& E) {
    int tid_ = threadIdx.x; asm volatile("" : "+v"(tid_));
    const int tid = tid_, wid = __builtin_amdgcn_readfirstlane(tid >> 6), lane = tid & 63, wr = wid >> 2, wc = wid & 3, fr = lane & 15, fq = lane >> 4;
    const int K = g.K, nt = K / BK;
    unsigned voffA[2], voffB[2];
#pragma unroll
    for (int i = 0; i < 2; ++i) { int R, C; stage_rc(tid * 16 + i * 8192, R, C); const int Rb = Epi::PERM ? ((R & ~31) + perm32(R & 31)) : R;
        voffA[i] = (unsigned)(R * K + C) * 2u; voffB[i] = (unsigned)(Rb * K + C) * 2u; }
    const size_t kstep = (size_t)(BK * 2);
    const size_t hstep = (size_t)HALF * K * 2;
    const size_t tstep = 2 * hstep;
    const unsigned ldsw = (unsigned)wid * 1024u;
    const int aoff = lds_byte(wr * 64 + fr, fq * 8), boff = lds_byte(wc * 32 + fr, fq * 8);
#define PG8_SA(b, h) (((b) * 2 + (h)) * HTB)
#define PG8_SB(b, h) ((4 + (b) * 2 + (h)) * HTB)
#define PG8_STAGE(bufoff, gbase, voff) do { _Pragma("unroll") for (int _i = 0; _i < 2; ++_i) \
        __builtin_amdgcn_global_load_lds((const unsigned*)((const char*)(gbase) + (voff)[_i]), (PG8_LAS unsigned*)(lds + (bufoff) + ldsw + _i * 8192), 16, 0, 0); } while (0)
#define PG8_LDA(dst, b, h) do { _Pragma("unroll") for (int m = 0; m < 4; ++m) _Pragma("unroll") for (int k = 0; k < 2; ++k) dst[m][k] = *(const PG8_LAS bf16x8*)(lds + PG8_SA(b, h) + aoff + m * 2048 + k * 1024); } while (0)
#define PG8_LDB(dst, b, h) do { _Pragma("unroll") for (int n = 0; n < 2; ++n) _Pragma("unroll") for (int k = 0; k < 2; ++k) dst[n][k] = *(const PG8_LAS bf16x8*)(lds + PG8_SB(b, h) + boff + n * 2048 + k * 1024); } while (0)
#define PG8_MMA(ai, bj, At, Bt) do { __builtin_amdgcn_s_setprio(1); _Pragma("unroll") for (int m = 0; m < 4; ++m) _Pragma("unroll") for (int n = 0; n < 2; ++n) _Pragma("unroll") for (int k = 0; k < 2; ++k) \
        acc[ai][bj][m][n] = __builtin_amdgcn_mfma_f32_16x16x32_bf16(Bt[n][k], At[m][k], acc[ai][bj][m][n], 0, 0, 0); __builtin_amdgcn_s_setprio(0); } while (0)
#define PG8_WAIT_V(n) asm volatile("s_waitcnt vmcnt(" #n ")" ::: "memory")
#define PG8_WAIT_L(n) asm volatile("s_waitcnt lgkmcnt(" #n ")" ::: "memory")
#define PG8_BAR __builtin_amdgcn_s_barrier()
#define PG8_SCHED __builtin_amdgcn_sched_barrier(0)
    Unit cur, nxt; int ui = 0;
    if (!S.next(0, cur)) return;
    f32x4 acc[2][2][4][2];
#pragma unroll
    for (int a = 0; a < 2; ++a)
#pragma unroll
        for (int b = 0; b < 2; ++b)
#pragma unroll
            for (int m = 0; m < 4; ++m)
#pragma unroll
                for (int n = 0; n < 2; ++n) acc[a][b][m][n] = (f32x4){0.f, 0.f, 0.f, 0.f};
    bf16x8 At[4][2], B0[2][2], B1[2][2];
    const char* cA = (const char*)g.A + (size_t)cur.pm * tstep; const char* cB = (const char*)g.Bt + (size_t)cur.pn * tstep;
    S.a_ready(cur);
    if constexpr (SP2) {
        PG8_STAGE(PG8_SB(0, 0), cB, voffB); PG8_STAGE(PG8_SB(0, 1), cB + hstep, voffB); PG8_STAGE(PG8_SA(0, 0), cA, voffA); PG8_STAGE(PG8_SA(0, 1), cA + hstep, voffA);
        if (wr == 1) PG8_BAR;
        PG8_WAIT_V(2); PG8_BAR;
        PG8_STAGE(PG8_SB(1, 0), cB + kstep, voffB); PG8_STAGE(PG8_SA(1, 0), cA + kstep, voffA); PG8_STAGE(PG8_SB(1, 1), cB + hstep + kstep, voffB);
        PG8_WAIT_V(6); PG8_BAR;
    } else {
        PG8_STAGE(PG8_SB(0, 0), cB, voffB); PG8_STAGE(PG8_SA(0, 0), cA, voffA); PG8_STAGE(PG8_SB(0, 1), cB + hstep, voffB); PG8_STAGE(PG8_SA(0, 1), cA + hstep, voffA);
        if (wr == 1) PG8_BAR;
        PG8_WAIT_V(4); PG8_BAR;
        PG8_STAGE(PG8_SB(1, 0), cB + kstep, voffB); PG8_STAGE(PG8_SA(1, 0), cA + kstep, voffA); PG8_STAGE(PG8_SB(1, 1), cB + hstep + kstep, voffB);
        PG8_WAIT_V(6); PG8_BAR;
    }
    for (;;) {
        const bool has_next = S.next(ui + 1, nxt);
        const char* nA = has_next ? (const char*)g.A + (size_t)nxt.pm * tstep : cA; const char* nB = has_next ? (const char*)g.Bt + (size_t)nxt.pn * tstep : cB;
        for (int t = 0; t < nt; t += 2) {
            const bool last = (t == nt - 2);
            const char* a1 = cA + (size_t)(t + 1) * kstep;
            const char* a2 = last ? nA : cA + (size_t)(t + 2) * kstep; const char* b2 = last ? nB : cB + (size_t)(t + 2) * kstep;
            const char* a3 = a2 + kstep; const char* b3 = b2 + kstep;
            if (last && has_next) S.a_ready(nxt);
            if constexpr (SP2) {
            PG8_LDB(B0, 0, 0); PG8_LDB(B1, 0, 1); PG8_SCHED; PG8_LDA(At, 0, 0); PG8_STAGE(PG8_SA(1, 1), a1 + hstep, voffA);
            PG8_WAIT_V(8); PG8_WAIT_L(0); PG8_BAR; PG8_MMA(0, 0, At, B0); PG8_MMA(0, 1, At, B1); PG8_BAR; PG8_SCHED;
            PG8_LDA(At, 0, 1); PG8_STAGE(PG8_SB(0, 0), b2, voffB); PG8_STAGE(PG8_SB(0, 1), b2 + hstep, voffB); PG8_STAGE(PG8_SA(0, 0), a2, voffA);
            PG8_WAIT_V(8); PG8_WAIT_L(0); PG8_BAR; PG8_MMA(1, 0, At, B0); PG8_MMA(1, 1, At, B1); PG8_BAR; PG8_SCHED;
            PG8_LDB(B0, 1, 0); PG8_LDB(B1, 1, 1); PG8_SCHED; PG8_LDA(At, 1, 0); PG8_STAGE(PG8_SA(0, 1), a2 + hstep, voffA);
            PG8_WAIT_V(8); PG8_WAIT_L(0); PG8_BAR; PG8_MMA(0, 0, At, B0); PG8_MMA(0, 1, At, B1); PG8_BAR; PG8_SCHED;
            PG8_LDA(At, 1, 1); PG8_STAGE(PG8_SB(1, 0), b3, voffB); PG8_STAGE(PG8_SB(1, 1), b3 + hstep, voffB); PG8_STAGE(PG8_SA(1, 0), a3, voffA);
            PG8_WAIT_V(8); PG8_WAIT_L(0); PG8_BAR; PG8_MMA(1, 0, At, B0); PG8_MMA(1, 1, At, B1); PG8_BAR; PG8_SCHED;
            } else {
            PG8_LDB(B0, 0, 0); PG8_SCHED; PG8_LDA(At, 0, 0); PG8_STAGE(PG8_SA(1, 1), a1 + hstep, voffA);
            PG8_WAIT_L(8); PG8_BAR; PG8_WAIT_L(0); PG8_MMA(0, 0, At, B0); PG8_BAR; PG8_SCHED;
            PG8_LDB(B1, 0, 1); PG8_STAGE(PG8_SB(0, 0), b2, voffB);
            PG8_BAR; PG8_WAIT_L(0); PG8_MMA(0, 1, At, B1); PG8_BAR;
            PG8_LDA(At, 0, 1); PG8_STAGE(PG8_SA(0, 0), a2, voffA);
            PG8_BAR; PG8_WAIT_L(0); PG8_MMA(1, 0, At, B0); PG8_BAR; PG8_SCHED;
            PG8_STAGE(PG8_SB(0, 1), b2 + hstep, voffB);
            PG8_WAIT_V(6); PG8_BAR; PG8_MMA(1, 1, At, B1); PG8_BAR;
            PG8_LDB(B0, 1, 0); PG8_SCHED; PG8_LDA(At, 1, 0); PG8_STAGE(PG8_SA(0, 1), a2 + hstep, voffA);
            PG8_WAIT_L(8); PG8_BAR; PG8_WAIT_L(0); PG8_MMA(0, 0, At, B0); PG8_BAR; PG8_SCHED;
            PG8_LDB(B1, 1, 1); PG8_STAGE(PG8_SB(1, 0), b3, voffB);
            PG8_BAR; PG8_WAIT_L(0); PG8_MMA(0, 1, At, B1); PG8_BAR;
            PG8_LDA(At, 1, 1); PG8_STAGE(PG8_SA(1, 0), a3, voffA);
            PG8_BAR; PG8_WAIT_L(0); PG8_MMA(1, 0, At, B0); PG8_BAR; PG8_SCHED;
            PG8_STAGE(PG8_SB(1, 1), b3 + hstep, voffB);
            PG8_WAIT_V(6); PG8_BAR; PG8_MMA(1, 1, At, B1); PG8_BAR;
            }
        }
        if constexpr (ALIGN_EPI) { if (wr == 0) PG8_BAR; }
        if constexpr (!Epi::AFTER_DRAIN) { E(acc, cur, wr, wc, fr, fq); S.done(cur); }
        if (!has_next) break;
#pragma unroll
        for (int a = 0; a < 2; ++a)
#pragma unroll
            for (int b = 0; b < 2; ++b)
#pragma unroll
                for (int m = 0; m < 4; ++m)
#pragma unroll
                    for (int n = 0; n < 2; ++n) acc[a][b][m][n] = (f32x4){0.f, 0.f, 0.f, 0.f};
        cur = nxt; cA = nA; cB = nB; ++ui;
        if constexpr (ALIGN_EPI) { if (wr == 1) PG8_BAR; }
    }
    PG8_WAIT_V(0);
    if constexpr (!ALIGN_EPI) { if (wr == 0) PG8_BAR; }
    PG8_BAR;
    if constexpr (Epi::AFTER_DRAIN) { E.fused(acc, cur, wr, wc, fr, fq, lds, wid, lane); S.done(cur); }
#undef PG8_SA
#undef PG8_SB
#undef PG8_STAGE
#undef PG8_LDA
#undef PG8_LDB
#undef PG8_MMA
#undef PG8_WAIT_V
#undef PG8_WAIT_L
#undef PG8_BAR
#undef PG8_SCHED
}
}

#define LAS __attribute__((address_space(3)))
typedef unsigned short bf16;
typedef float f32x4 __attribute__((ext_vector_type(4)));
typedef float f32x2 __attribute__((ext_vector_type(2)));
typedef unsigned u32x4 __attribute__((ext_vector_type(4)));
typedef unsigned u32x2 __attribute__((ext_vector_type(2)));
typedef short bf16x8 __attribute__((ext_vector_type(8)));

constexpr int NB = 4, SEQ = 2048, DM = 2048, MT = NB * SEQ, NMOD = 6 * DM;
constexpr int NIN = 3904, NINP = 4096, QLR = 512, KVLR = 256, NQB = 1536, NKVB = 2048, DFF = 8192;
constexpr float EPS = 1e-6f, LOG2E = 1.4426950408889634f;
constexpr float QS_D = 0.125f * LOG2E;
constexpr float QS_M = 0.07216878364870322f * LOG2E;
constexpr float LAMBDA_INIT = 0.2f;

constexpr size_t MiB = 1u << 20;
constexpr size_t WS_CTL = 0, CTL_ZERO_BYTES = 1 * MiB;
constexpr size_t WS_MODP = 1 * MiB;
constexpr size_t WS_MOD = 7 * MiB;
constexpr size_t WS_ROPED = 8 * MiB;
constexpr size_t WS_ROPEM = 8 * MiB + 512 * 1024;
constexpr size_t WS_SSQQ = 11 * MiB;
constexpr size_t WS_SSQKV = 11 * MiB + 256 * 1024;
constexpr size_t WS_SSQ2 = 11 * MiB + 512 * 1024;
constexpr size_t WS_SSQ3 = 11 * MiB + 768 * 1024;
constexpr size_t WS_TB = 12 * MiB;
constexpr size_t WS_LAM = 12 * MiB + 512 * 1024;
constexpr size_t WS_WIN = 16 * MiB;
constexpr size_t WS_WQB = 32 * MiB;
constexpr size_t WS_WKVB = 34 * MiB;
constexpr size_t WS_WOUT = 36 * MiB;
constexpr size_t WS_W1 = 44 * MiB;
constexpr size_t WS_W2 = 76 * MiB;
constexpr size_t WS_MIX = 108 * MiB;
constexpr size_t WS_A2 = 140 * MiB;
constexpr size_t WS_H = 172 * MiB;
constexpr size_t WS_XN = 172 * MiB;
constexpr size_t WS_QD = 204 * MiB;
constexpr size_t WS_KD = 220 * MiB;
constexpr size_t WS_VD = 236 * MiB;
constexpr size_t WS_QLAT = 252 * MiB;
constexpr size_t WS_KVLAT = 260 * MiB;
constexpr size_t WS_QM = 264 * MiB;
constexpr size_t WS_KM = 300 * MiB;
constexpr size_t WS_VM = 324 * MiB;
constexpr size_t WS_OST = 340 * MiB;
constexpr size_t WS_END = 372 * MiB;

constexpr int LDS_BYTES = 147456;

struct Ctx {
    const float *x, *c; const int* pos; const float *w_ada, *b_ada, *g_mix, *w_in, *lq1, *lk1, *lq2, *lk2, *g_dsub, *g_qa, *w_qb, *g_kva, *w_kvb, *w_out, *g_ffn, *w_ff1, *w_ff2, *g_fin;
    float* out; unsigned char* ws;
};
#define WSP(T, off) ((T*)(c.ws + (off)))

__constant__ double INV_D[8] = {1.0, 0.19392274474868576, 0.03760603093086393, 0.007292664737217109, 0.001414213562373095, 0.0002742481756762073, 5.318295896944988e-05, 1.031338537721246e-05};
__constant__ double INV_M[32] = {1.0, 0.7498942093324559, 0.5623413251903491, 0.4216965034285822, 0.31622776601683794, 0.23713737056616552, 0.1778279410038923, 0.1333521432163324, 0.1, 0.07498942093324558, 0.05623413251903491, 0.042169650342858224, 0.03162277660168379, 0.023713737056616554, 0.01778279410038923, 0.01333521432163324, 0.01, 0.007498942093324558, 0.005623413251903491, 0.004216965034285823, 0.0031622776601683794, 0.0023713737056616554, 0.0017782794100389228, 0.001333521432163324, 0.001, 0.0007498942093324559, 0.0005623413251903491, 0.00042169650342858224, 0.00031622776601683794, 0.00023713737056616554, 0.00017782794100389227, 0.0001333521432163324};

#define LDS_WAIT() asm volatile("s_waitcnt lgkmcnt(0)" ::: "memory")
#define VM_WAIT() asm volatile("s_waitcnt vmcnt(0)" ::: "memory")
__device__ __forceinline__ int rfl(int v) { return __builtin_amdgcn_readfirstlane(v); }
__device__ __forceinline__ unsigned pk2(float lo, float hi) { return pg8::cvt_pk_bf16(lo, hi); }
__device__ __forceinline__ float bflo(unsigned w) { return __builtin_bit_cast(float, w << 16); }
__device__ __forceinline__ float bfhi(unsigned w) { return __builtin_bit_cast(float, w & 0xffff0000u); }
__device__ __forceinline__ float bf2f(bf16 h) { return __builtin_bit_cast(float, (unsigned)h << 16); }
__device__ __forceinline__ float wave_sum(float v) {
#pragma unroll
    for (int o = 1; o < 64; o <<= 1) v += __shfl_xor(v, o);
    return v;
}
__device__ __forceinline__ float wave_max(float v) {
#pragma unroll
    for (int o = 1; o < 64; o <<= 1) v = fmaxf(v, __shfl_xor(v, o));
    return v;
}
__device__ __forceinline__ float dot4(f32x4 a, f32x4 b) { return (a[0] * b[0] + a[1] * b[1]) + (a[2] * b[2] + a[3] * b[3]); }
__device__ __forceinline__ f32x4 rope4(f32x4 v, f32x4 cs) { return (f32x4){v[0] * cs[0] - v[1] * cs[1], v[1] * cs[0] + v[0] * cs[1], v[2] * cs[2] - v[3] * cs[3], v[3] * cs[2] + v[2] * cs[3]}; }
__device__ __forceinline__ void st_bf4(bf16* p, f32x4 v) { u32x2 w; w.x = pk2(v[0], v[1]); w.y = pk2(v[2], v[3]); *(u32x2*)p = w; }

__device__ __forceinline__ void adaln_job(const Ctx& c, int job, int lane) {
    const int cj = job % 48, ks = job / 48;
    const int n0 = cj * 256 + lane * 4, k0 = ks * 64;
    float sl[4];
#pragma unroll
    for (int b = 0; b < 4; ++b) { const float v = c.c[b * DM + k0 + lane]; sl[b] = v / (1.f + __expf(-v)); }
    f32x4 acc[4];
#pragma unroll
    for (int b = 0; b < 4; ++b) acc[b] = (f32x4){0.f, 0.f, 0.f, 0.f};
    const float* wp = c.w_ada + (size_t)k0 * NMOD + n0;
#pragma unroll 8
    for (int kk = 0; kk < 64; ++kk) {
        const f32x4 w = *(const f32x4*)(wp + (size_t)kk * NMOD);
#pragma unroll
        for (int b = 0; b < 4; ++b) { const float s = __shfl(sl[b], kk); acc[b] += w * s; }
    }
    float* modp = WSP(float, WS_MODP);
#pragma unroll
    for (int b = 0; b < 4; ++b) *(f32x4*)(modp + (size_t)(ks * 4 + b) * NMOD + n0) = acc[b];
}
template <int MAP> __device__ __forceinline__ int dst_row(int s) {
    if (MAP == 1) {
        if (s < 2048) { const int d = s & 63; const int j = d < 8 ? 2 * d : (d < 16 ? 2 * (d - 8) + 1 : d); return (s & ~63) | j; }
        if (s < 3840) return s;
        const int d = s - 3840; return 3840 + (d < 32 ? 2 * d : 2 * (d - 32) + 1);
    }
    if (MAP == 2) {
        const int h = s / 192, j = s - h * 192; if (j < 128) return s;
        const int d = j - 128; return h * 192 + 128 + (d < 32 ? 2 * d : 2 * (d - 32) + 1);
    }
    return s;
}
template <int MAP, int KSM> __device__ __forceinline__ void tr_item(const float* W, int K, int N, bf16* WT, const float* ks, LAS float* scr, int item, int lane) {
    const int nblk = N / 32, kb = item / nblk, nb = item - kb * nblk, k0 = 64 * kb, n0 = 32 * nb;
#pragma unroll 8
    for (int i = 0; i < 32; ++i) { const int kk = 2 * i + (lane >> 5); float v = W[(size_t)(k0 + kk) * N + n0 + (lane & 31)];
        if (KSM == 1) v *= ks[k0 + kk];
        if (KSM == 2) { const int k = k0 + kk; if (k < 1024) v *= ks[k & 127] * (1.f - LAMBDA_INIT); }
        scr[kk * 33 + (lane & 31)] = v; }
    LDS_WAIT(); asm volatile("" ::: "memory");
    const int cc = lane & 7;
#pragma unroll
    for (int j = 0; j < 4; ++j) { const int n = (lane >> 3) + 8 * j; const LAS float* s = scr + (8 * cc) * 33 + n;
        u32x4 o; o.x = pk2(s[0 * 33], s[1 * 33]); o.y = pk2(s[2 * 33], s[3 * 33]); o.z = pk2(s[4 * 33], s[5 * 33]); o.w = pk2(s[6 * 33], s[7 * 33]);
        *(u32x4*)(WT + (size_t)dst_row<MAP>(n0 + n) * K + k0 + 8 * cc) = o; }
    LDS_WAIT(); asm volatile("" ::: "memory");
}
__device__ __forceinline__ void sincos_d(double x, float& cs, float& sn) {
    const double q = __builtin_rint(x * 0.63661977236758134308);
    double r = __builtin_fma(-q, 1.57079632679489655800e+00, x); r = __builtin_fma(-q, 6.12323399573676603587e-17, r);
    const double r2 = r * r;
    const double s = r * (1.0 + r2 * (-1.0 / 6 + r2 * (1.0 / 120 + r2 * (-1.0 / 5040 + r2 * (1.0 / 362880 + r2 * (-1.0 / 39916800))))));
    const double co = 1.0 + r2 * (-0.5 + r2 * (1.0 / 24 + r2 * (-1.0 / 720 + r2 * (1.0 / 40320 + r2 * (-1.0 / 3628800 + r2 * (1.0 / 479001600))))));
    const int qi = (int)q & 3;
    double cc = (qi & 1) ? s : co, ss = (qi & 1) ? co : s;
    if (qi == 1 || qi == 2) cc = -cc;
    if (qi == 2 || qi == 3) ss = -ss;
    cs = (float)cc; sn = (float)ss;
}
__device__ __forceinline__ void rope_job(const Ctx& c, int job, int lane) {
    const int row = job * 64 + lane; const double p = (double)c.pos[row];
    f32x2* rd = WSP(f32x2, WS_ROPED) + (size_t)row * 8; f32x2* rm = WSP(f32x2, WS_ROPEM) + (size_t)row * 32;
    for (int i = 0; i < 8; ++i) { float cs, sn; sincos_d(p * INV_D[i], cs, sn); rd[i] = (f32x2){cs, sn}; }
    for (int i = 0; i < 32; ++i) { float cs, sn; sincos_d(p * INV_M[i], cs, sn); rm[i] = (f32x2){cs, sn}; }
}
__device__ __forceinline__ void phase_p0a(const Ctx& c, LAS unsigned char* lds) {
    const int tid = threadIdx.x, lane = tid & 63, wave = rfl(tid >> 6);
    const int gw = blockIdx.x * 8 + wave, NGW = gridDim.x * 8;
    LAS float* scr = (LAS float*)(lds + wave * 16384);
    constexpr int J_ADA = 48 * 32;
    constexpr int I_F1 = (DM / 64) * (DFF / 32), I_F2 = (DFF / 64) * (DM / 32), I_IN = (DM / 64) * (NIN / 32), I_OUT = (DM / 64) * (DM / 32), I_QB = (QLR / 64) * (NQB / 32), I_KVB = (KVLR / 64) * (NKVB / 32);
    constexpr int J_ROPE = MT / 64, J_PAD = NINP - NIN, J_LAM = 1;
    constexpr int TOTAL = J_ADA + I_F1 + I_F2 + I_IN + I_OUT + I_QB + I_KVB + J_ROPE + J_PAD + J_LAM;
    for (int it = gw; it < TOTAL; it += NGW) {
        int r = it;
        if (r < J_ADA) { adaln_job(c, r, lane); continue; } r -= J_ADA;
        if (r < I_F1) { tr_item<0, 0>(c.w_ff1, DM, DFF, WSP(bf16, WS_W1), nullptr, scr, r, lane); continue; } r -= I_F1;
        if (r < I_F2) { tr_item<0, 0>(c.w_ff2, DFF, DM, WSP(bf16, WS_W2), nullptr, scr, r, lane); continue; } r -= I_F2;
        if (r < I_IN) { tr_item<1, 0>(c.w_in, DM, NIN, WSP(bf16, WS_WIN), nullptr, scr, r, lane); continue; } r -= I_IN;
        if (r < I_OUT) { tr_item<0, 2>(c.w_out, DM, DM, WSP(bf16, WS_WOUT), c.g_dsub, scr, r, lane); continue; } r -= I_OUT;
        if (r < I_QB) { tr_item<2, 1>(c.w_qb, QLR, NQB, WSP(bf16, WS_WQB), c.g_qa, scr, r, lane); continue; } r -= I_QB;
        if (r < I_KVB) { tr_item<0, 1>(c.w_kvb, KVLR, NKVB, WSP(bf16, WS_WKVB), c.g_kva, scr, r, lane); continue; } r -= I_KVB;
        if (r < J_ROPE) { rope_job(c, r, lane); continue; } r -= J_ROPE;
        if (r < J_PAD) { u32x4* p = (u32x4*)(WSP(bf16, WS_WIN) + (size_t)(NIN + r) * DM);
#pragma unroll
            for (int j = 0; j < 4; ++j) p[lane + 64 * j] = (u32x4){0u, 0u, 0u, 0u};
            continue; } r -= J_PAD;
        {
            const float a = wave_sum(c.lq1[lane] * c.lk1[lane]), b = wave_sum(c.lq2[lane] * c.lk2[lane]);
            if (lane == 0) *WSP(float, WS_LAM) = __expf(a) - __expf(b) + LAMBDA_INIT;
        }
    }
}
__device__ __forceinline__ void phase_p0b(const Ctx& c) {
    const float* modp = WSP(float, WS_MODP); float* mod = WSP(float, WS_MOD);
    for (int i = blockIdx.x * 512 + threadIdx.x; i < 4 * NMOD; i += gridDim.x * 512) {
        const int n = i % NMOD, b = i / NMOD; float s = c.b_ada[n];
#pragma unroll 8
        for (int ks = 0; ks < 32; ++ks) s += modp[(size_t)(ks * 4 + b) * NMOD + n];
        mod[i] = s;
    }
}
__device__ __forceinline__ void phase_p0c(const Ctx& c, LAS unsigned char* lds) {
    const int tid = threadIdx.x, lane = tid & 63, wave = rfl(tid >> 6);
    const int gw = blockIdx.x * 8 + wave, NGW = gridDim.x * 8;
    const float* mod = WSP(float, WS_MOD);
    LAS float* shl = (LAS float*)lds;
    for (int i = tid; i < 4 * DM; i += 512) shl[i] = mod[(size_t)(i >> 11) * NMOD + 3 * DM + (i & 2047)];
    __syncthreads();
    const bf16* W1T = WSP(bf16, WS_W1); float* TB = WSP(float, WS_TB);
    for (int n = gw; n < DFF; n += NGW) {
        float acc[4] = {0.f, 0.f, 0.f, 0.f};
#pragma unroll
        for (int j2 = 0; j2 < 4; ++j2) { const int k = (j2 * 64 + lane) * 8; const u32x4 w = *(const u32x4*)(W1T + (size_t)n * DM + k);
            const f32x4 w0 = {bflo(w.x), bfhi(w.x), bflo(w.y), bfhi(w.y)}, w1 = {bflo(w.z), bfhi(w.z), bflo(w.w), bfhi(w.w)};
#pragma unroll
            for (int b = 0; b < 4; ++b) { const f32x4 s0 = *(const LAS f32x4*)(shl + b * DM + k), s1 = *(const LAS f32x4*)(shl + b * DM + k + 4); acc[b] += dot4(w0, s0) + dot4(w1, s1); } }
#pragma unroll
        for (int b = 0; b < 4; ++b) { const float t = wave_sum(acc[b]); if (lane == 0) TB[b * DFF + n] = t; }
    }
    bf16* XN = WSP(bf16, WS_XN);
    for (int row = gw; row < MT; row += NGW) {
        const int b = row >> 11; const f32x4* xr = (const f32x4*)(c.x + (size_t)row * DM) + lane;
        f32x4 v[8]; float ss = 0.f;
#pragma unroll
        for (int j = 0; j < 8; ++j) { v[j] = xr[64 * j]; ss += dot4(v[j], v[j]); }
        const float rstd = 1.0f / sqrtf(wave_sum(ss) * (1.f / DM) + EPS);
#pragma unroll
        for (int j = 0; j < 8; ++j) { const int col = 4 * lane + 256 * j;
            const f32x4 g = *(const f32x4*)(c.g_mix + col), sc = *(const f32x4*)(mod + (size_t)b * NMOD + DM + col), sh = *(const f32x4*)(mod + (size_t)b * NMOD + col);
            st_bf4(XN + (size_t)row * DM + col, v[j] * rstd * g * (1.f + sc) + sh); }
    }
}

struct EpiIn {
    static constexpr bool PERM = false, AFTER_DRAIN = false;
    Ctx c;
    __device__ __forceinline__ void operator()(const pg8::f32x4 (&acc)[2][2][4][2], const pg8::Unit& u, int wr, int wc, int fr, int fq) const {
        const int pn = u.pn; const f32x4* ropeD = (const f32x4*)WSP(f32x2, WS_ROPED); const f32x4* ropeM = (const f32x4*)WSP(f32x2, WS_ROPEM);
#pragma unroll
        for (int ai = 0; ai < 2; ++ai)
#pragma unroll
            for (int m = 0; m < 4; ++m) {
                const int row = u.pm * 256 + ai * 128 + wr * 64 + m * 16 + fr;
                if (pn < 8) {
                    bf16* dst = (pn < 4 ? WSP(bf16, WS_QD) : WSP(bf16, WS_KD)) + (size_t)row * 1024 + (pn & 3) * 256 + wc * 32 + 4 * fq;
                    const float sc = pn < 4 ? QS_D : 1.f;
                    const bool rp = (wc & 1) == 0;
                    f32x4 cs = {1.f, 0.f, 1.f, 0.f}; if (rp) cs = ropeD[(size_t)row * 4 + fq];
#pragma unroll
                    for (int bj = 0; bj < 2; ++bj)
#pragma unroll
                        for (int n = 0; n < 2; ++n) { f32x4 v = acc[ai][bj][m][n]; if (n == 0 && rp) v = rope4(v, cs); st_bf4(dst + bj * 128 + n * 16, v * sc); }
                } else if (pn < 12) {
                    bf16* dst = WSP(bf16, WS_VD) + (size_t)row * 1024 + (pn - 8) * 256 + wc * 32 + 4 * fq;
#pragma unroll
                    for (int bj = 0; bj < 2; ++bj)
#pragma unroll
                        for (int n = 0; n < 2; ++n) st_bf4(dst + bj * 128 + n * 16, acc[ai][bj][m][n]);
                } else if (pn < 15) {
                    bf16* dst = pn < 14 ? WSP(bf16, WS_QLAT) + (size_t)row * QLR + (pn - 12) * 256 + wc * 32 + 4 * fq : WSP(bf16, WS_KVLAT) + (size_t)row * KVLR + wc * 32 + 4 * fq;
                    float s = 0.f;
#pragma unroll
                    for (int bj = 0; bj < 2; ++bj)
#pragma unroll
                        for (int n = 0; n < 2; ++n) { const f32x4 v = acc[ai][bj][m][n]; s += dot4(v, v); st_bf4(dst + bj * 128 + n * 16, v); }
                    s += __shfl_xor(s, 16); s += __shfl_xor(s, 32);
                    if (fq == 0) { if (pn < 14) WSP(float, WS_SSQQ)[(size_t)row * 8 + (pn - 12) * 4 + wc] = s; else WSP(float, WS_SSQKV)[(size_t)row * 4 + wc] = s; }
                } else {
                    if (wc < 2) {
                        bf16* dst = WSP(bf16, WS_KM) + (size_t)row * NQB + 128 + wc * 32 + 4 * fq;
#pragma unroll
                        for (int n = 0; n < 2; ++n) { const int cc = wc * 32 + n * 16 + 4 * fq; const f32x4 cs = ropeM[(size_t)row * 16 + (cc >> 2)];
                            const f32x4 v = rope4(acc[ai][0][m][n], cs);
#pragma unroll
                            for (int h = 0; h < 8; ++h) st_bf4(dst + h * 192 + n * 16, v); }
                    }
                }
            }
    }
};
struct EpiQB {
    static constexpr bool PERM = false, AFTER_DRAIN = false;
    Ctx c;
    __device__ __forceinline__ void operator()(const pg8::f32x4 (&acc)[2][2][4][2], const pg8::Unit& u, int wr, int wc, int fr, int fq) const {
        const f32x4* ropeM = (const f32x4*)WSP(f32x2, WS_ROPEM); const f32x4* ssq = (const f32x4*)WSP(float, WS_SSQQ);
#pragma unroll
        for (int ai = 0; ai < 2; ++ai)
#pragma unroll
            for (int m = 0; m < 4; ++m) {
                const int row = u.pm * 256 + ai * 128 + wr * 64 + m * 16 + fr;
                const f32x4 s0 = ssq[(size_t)row * 2], s1 = ssq[(size_t)row * 2 + 1];
                const float rstd = QS_M / sqrtf(((s0[0] + s0[1]) + (s0[2] + s0[3]) + (s1[0] + s1[1]) + (s1[2] + s1[3])) * (1.f / QLR) + EPS);
#pragma unroll
                for (int bj = 0; bj < 2; ++bj)
#pragma unroll
                    for (int n = 0; n < 2; ++n) { const int col = u.pn * 256 + bj * 128 + wc * 32 + n * 16 + 4 * fq; const int h = col / 192, j = col - h * 192;
                        f32x4 v = acc[ai][bj][m][n] * rstd;
                        if (j >= 128) v = rope4(v, ropeM[(size_t)row * 16 + ((j - 128) >> 2)]);
                        st_bf4(WSP(bf16, WS_QM) + (size_t)row * NQB + col, v); }
            }
    }
};
struct EpiKVB {
    static constexpr bool PERM = false, AFTER_DRAIN = false;
    Ctx c;
    __device__ __forceinline__ void operator()(const pg8::f32x4 (&acc)[2][2][4][2], const pg8::Unit& u, int wr, int wc, int fr, int fq) const {
        const f32x4* ssq = (const f32x4*)WSP(float, WS_SSQKV);
        const int h = u.pn;
#pragma unroll
        for (int ai = 0; ai < 2; ++ai)
#pragma unroll
            for (int m = 0; m < 4; ++m) {
                const int row = u.pm * 256 + ai * 128 + wr * 64 + m * 16 + fr;
                const f32x4 s0 = ssq[row];
                const float rstd = 1.0f / sqrtf(((s0[0] + s0[1]) + (s0[2] + s0[3])) * (1.f / KVLR) + EPS);
#pragma unroll
                for (int n = 0; n < 2; ++n) { const int j = wc * 32 + n * 16 + 4 * fq;
                    st_bf4(WSP(bf16, WS_KM) + (size_t)row * NQB + h * 192 + j, acc[ai][0][m][n] * rstd);
                    st_bf4(WSP(bf16, WS_VM) + (size_t)row * 1024 + h * 128 + j, acc[ai][1][m][n] * rstd); }
            }
    }
};
__device__ __forceinline__ void tile_ssq_publish(PG8_LAS unsigned char* lds, float* slots, const pg8::Unit& u) {
    asm volatile("s_waitcnt lgkmcnt(0)" ::: "memory"); __builtin_amdgcn_s_barrier(); asm volatile("" ::: "memory");
    const int t = threadIdx.x;
    if (t < 256) { const f32x4 p = *(const PG8_LAS f32x4*)(lds + t * 16); slots[(size_t)(u.pm * 256 + t) * 8 + u.pn] = (p[0] + p[1]) + (p[2] + p[3]); }
}
struct EpiOut {
    static constexpr bool PERM = false, AFTER_DRAIN = true;
    Ctx c;
    __device__ __forceinline__ void fused(pg8::f32x4 (&acc)[2][2][4][2], const pg8::Unit& u, int wr, int wc, int fr, int fq, PG8_LAS unsigned char* lds, int wid, int lane) const {
        PG8_LAS float* P = (PG8_LAS float*)lds; const float* mod = WSP(float, WS_MOD);
        const int col0 = u.pn * 256 + wc * 32 + 4 * fq;
#pragma unroll
        for (int ai = 0; ai < 2; ++ai)
#pragma unroll
            for (int m = 0; m < 4; ++m) {
                const int rt = ai * 128 + wr * 64 + m * 16 + fr, row = u.pm * 256 + rt, b = row >> 11; float s = 0.f;
#pragma unroll
                for (int bj = 0; bj < 2; ++bj)
#pragma unroll
                    for (int n = 0; n < 2; ++n) { const int col = col0 + bj * 128 + n * 16; const size_t off = (size_t)row * DM + col;
                        const f32x4 gate = *(const f32x4*)(mod + (size_t)b * NMOD + 2 * DM + col), xv = *(const f32x4*)(c.x + off);
                        const f32x4 v = xv + gate * acc[ai][bj][m][n];
                        *(f32x4*)(c.out + off) = v; s += dot4(v, v);
                        const f32x4 gs = *(const f32x4*)(c.g_ffn + col) * (1.f + *(const f32x4*)(mod + (size_t)b * NMOD + 4 * DM + col));
                        st_bf4(WSP(bf16, WS_A2) + off, v * gs); }
                s += __shfl_xor(s, 16); s += __shfl_xor(s, 32);
                if (fq == 0) P[rt * 4 + wc] = s;
            }
        tile_ssq_publish(lds, WSP(float, WS_SSQ2), u);
    }
};
struct EpiF1 {
    static constexpr bool PERM = false, AFTER_DRAIN = false;
    Ctx c;
    __device__ __forceinline__ void operator()(const pg8::f32x4 (&acc)[2][2][4][2], const pg8::Unit& u, int wr, int wc, int fr, int fq) const {
        const f32x4* ssq = (const f32x4*)WSP(float, WS_SSQ2); const float* TB = WSP(float, WS_TB);
        const int col0 = u.pn * 256 + wc * 32 + 4 * fq, b = (u.pm * 256) >> 11;
        f32x4 tb[2][2];
#pragma unroll
        for (int bj = 0; bj < 2; ++bj)
#pragma unroll
            for (int n = 0; n < 2; ++n) tb[bj][n] = *(const f32x4*)(TB + (size_t)b * DFF + col0 + bj * 128 + n * 16);
#pragma unroll
        for (int ai = 0; ai < 2; ++ai)
#pragma unroll
            for (int m = 0; m < 4; ++m) {
                const int row = u.pm * 256 + ai * 128 + wr * 64 + m * 16 + fr;
                const f32x4 s0 = ssq[(size_t)row * 2], s1 = ssq[(size_t)row * 2 + 1];
                const float rstd = 1.0f / sqrtf(((s0[0] + s0[1]) + (s0[2] + s0[3]) + (s1[0] + s1[1]) + (s1[2] + s1[3])) * (1.f / DM) + EPS);
#pragma unroll
                for (int bj = 0; bj < 2; ++bj)
#pragma unroll
                    for (int n = 0; n < 2; ++n) { f32x4 v = acc[ai][bj][m][n] * rstd + tb[bj][n];
                        v = __builtin_elementwise_max(v, (f32x4){0.f, 0.f, 0.f, 0.f}); v = v * v;
                        st_bf4(WSP(bf16, WS_H) + (size_t)row * DFF + col0 + bj * 128 + n * 16, v); }
            }
    }
};
struct EpiF2 {
    static constexpr bool PERM = false, AFTER_DRAIN = true;
    Ctx c;
    __device__ __forceinline__ void fused(pg8::f32x4 (&acc)[2][2][4][2], const pg8::Unit& u, int wr, int wc, int fr, int fq, PG8_LAS unsigned char* lds, int wid, int lane) const {
        PG8_LAS float* P = (PG8_LAS float*)lds; const float* mod = WSP(float, WS_MOD);
        const int col0 = u.pn * 256 + wc * 32 + 4 * fq;
#pragma unroll
        for (int ai = 0; ai < 2; ++ai)
#pragma unroll
            for (int m = 0; m < 4; ++m) {
                const int rt = ai * 128 + wr * 64 + m * 16 + fr, row = u.pm * 256 + rt, b = row >> 11; float s = 0.f;
#pragma unroll
                for (int bj = 0; bj < 2; ++bj)
#pragma unroll
                    for (int n = 0; n < 2; ++n) { const int col = col0 + bj * 128 + n * 16; const size_t off = (size_t)row * DM + col;
                        const f32x4 gate = *(const f32x4*)(mod + (size_t)b * NMOD + 5 * DM + col), xv = *(const f32x4*)(c.out + off);
                        const f32x4 v = xv + gate * acc[ai][bj][m][n];
                        *(f32x4*)(c.out + off) = v; s += dot4(v, v); }
                s += __shfl_xor(s, 16); s += __shfl_xor(s, 32);
                if (fq == 0) P[rt * 4 + wc] = s;
            }
        tile_ssq_publish(lds, WSP(float, WS_SSQ3), u);
    }
};

template <class Epi> __device__ __forceinline__ void run_gemm(LAS unsigned char* lds, const bf16* A, const bf16* Bt, int M, int N, int K, const Epi& E) {
    pg8::Gemm g{A, Bt, M, N, K}; pg8::StaticOrder S; S.init(M, N, (int)gridDim.x, (int)blockIdx.x);
    pg8::gemm_phase<Epi, pg8::StaticOrder, !Epi::AFTER_DRAIN, true>(lds, g, S, E);
}

template <int DQK> __device__ __forceinline__ void naive_attn_head(const bf16* q, const bf16* K, int ldk, const bf16* V, int ldv, LAS float* qf, LAS float* pl, int lane, float (&o)[2]) {
    for (int d = lane; d < DQK; d += 64) qf[d] = bf2f(q[d]);
    LDS_WAIT(); asm volatile("" ::: "memory");
    float mx = -1e30f;
    for (int t = 0; t < 32; ++t) { const bf16* kr = K + (size_t)(t * 64 + lane) * ldk; float a = 0.f;
#pragma unroll
        for (int d = 0; d < DQK; d += 8) { const u32x4 w = *(const u32x4*)(kr + d); const f32x4 q0 = *(const LAS f32x4*)(qf + d), q1 = *(const LAS f32x4*)(qf + d + 4);
            a += dot4((f32x4){bflo(w.x), bfhi(w.x), bflo(w.y), bfhi(w.y)}, q0) + dot4((f32x4){bflo(w.z), bfhi(w.z), bflo(w.w), bfhi(w.w)}, q1); }
        pl[t * 64 + lane] = a; mx = fmaxf(mx, a); }
    mx = wave_max(mx); float l = 0.f;
    LDS_WAIT(); asm volatile("" ::: "memory");
    for (int t = 0; t < 32; ++t) { const float p = __builtin_amdgcn_exp2f(pl[t * 64 + lane] - mx); l += p; pl[t * 64 + lane] = p; }
    l = wave_sum(l);
    LDS_WAIT(); asm volatile("" ::: "memory");
    float a0 = 0.f, a1 = 0.f;
#pragma unroll 8
    for (int k = 0; k < SEQ; ++k) { const unsigned w = *(const unsigned*)(V + (size_t)k * ldv + 2 * lane); const float p = pl[k]; a0 += p * bflo(w); a1 += p * bfhi(w); }
    const float il = 1.f / l; o[0] = a0 * il; o[1] = a1 * il;
    LDS_WAIT(); asm volatile("" ::: "memory");
}
__device__ __forceinline__ void phase_attn_naive(const Ctx& c, LAS unsigned char* lds) {
    const int tid = threadIdx.x, lane = tid & 63, wave = rfl(tid >> 6);
    const int gw = blockIdx.x * 8 + wave, NGW = gridDim.x * 8;
    LAS float* qf = (LAS float*)(lds + wave * 16384); LAS float* pl = qf + 256;
    const float lam = __builtin_bit_cast(float, __hip_atomic_load(WSP(unsigned, WS_LAM), __ATOMIC_RELAXED, __HIP_MEMORY_SCOPE_AGENT));
    bf16* MIX = WSP(bf16, WS_MIX);
    for (int job = gw; job < 2 * MT * 8; job += NGW) {
        const int type = job / (MT * 8), rh = job - type * (MT * 8), row = rh >> 3, h = rh & 7, kb = row & ~(SEQ - 1);
        if (type == 0) {
            float o1[2], o2[2];
            naive_attn_head<64>(WSP(bf16, WS_QD) + (size_t)row * 1024 + h * 128, WSP(bf16, WS_KD) + (size_t)kb * 1024 + h * 128, 1024, WSP(bf16, WS_VD) + (size_t)kb * 1024 + h * 128, 1024, qf, pl, lane, o1);
            naive_attn_head<64>(WSP(bf16, WS_QD) + (size_t)row * 1024 + h * 128 + 64, WSP(bf16, WS_KD) + (size_t)kb * 1024 + h * 128 + 64, 1024, WSP(bf16, WS_VD) + (size_t)kb * 1024 + h * 128, 1024, qf, pl, lane, o2);
            const float a = o1[0] - lam * o2[0], b = o1[1] - lam * o2[1];
            const float rstd = 1.0f / sqrtf(wave_sum(a * a + b * b) * (1.f / 128.f) + EPS);
            *(unsigned*)(MIX + (size_t)row * DM + h * 128 + 2 * lane) = pk2(a * rstd, b * rstd);
        } else {
            float o[2];
            naive_attn_head<192>(WSP(bf16, WS_QM) + (size_t)row * NQB + h * 192, WSP(bf16, WS_KM) + (size_t)kb * NQB + h * 192, NQB, WSP(bf16, WS_VM) + (size_t)kb * 1024 + h * 128, 1024, qf, pl, lane, o);
            *(unsigned*)(MIX + (size_t)row * DM + 1024 + h * 128 + 2 * lane) = pk2(o[0], o[1]);
        }
    }
}
namespace att {
typedef float f32x16 __attribute__((ext_vector_type(16)));
typedef short s16x4 __attribute__((ext_vector_type(4)));
constexpr float THR2 = 8.f * 1.4426950408889634f;
constexpr int NSLOT = 3;
#define SBAR() __builtin_amdgcn_sched_barrier(0)
__device__ __forceinline__ int crow(int r, int hi) { return (r & 3) + 8 * (r >> 2) + 4 * hi; }
__device__ __forceinline__ void glds16(const void* gsrc, unsigned lds_dst) { unsigned keep;
    asm volatile("s_mov_b32 %0, m0\n\ts_mov_b32 m0, %2\n\ts_nop 0\n\tglobal_load_lds_dwordx4 %1, off\n\ts_mov_b32 m0, %0" : "=&s"(keep) : "v"(gsrc), "s"(lds_dst) : "memory"); }
__device__ __forceinline__ int v_rd_base(int lane) { return ((lane & 3) << 3) | (((lane >> 2) & 3) << 6) | (((lane >> 4) & 1) << 5) | (((lane >> 5) & 1) << 8); }
constexpr int v_rd_off(int d0, int ks, int half) { return d0 * 512 + ks * 4096 + half * 2048; }
template <int OFF> __device__ __forceinline__ s16x4 tr_read(int vb) { s16x4 r; asm volatile("ds_read_b64_tr_b16 %0, %1 offset:%2" : "=&v"(r) : "v"(vb), "i"(OFF) : "memory"); return r; }
template <int D0> __device__ __forceinline__ void pv_one(f32x16& od, int vb, bf16x8 pa0, bf16x8 pa1, bf16x8 pa2, bf16x8 pa3) {
    const s16x4 l0 = tr_read<v_rd_off(D0, 0, 0)>(vb), h0 = tr_read<v_rd_off(D0, 0, 1)>(vb), l1 = tr_read<v_rd_off(D0, 1, 0)>(vb), h1 = tr_read<v_rd_off(D0, 1, 1)>(vb);
    const s16x4 l2 = tr_read<v_rd_off(D0, 2, 0)>(vb), h2 = tr_read<v_rd_off(D0, 2, 1)>(vb), l3 = tr_read<v_rd_off(D0, 3, 0)>(vb), h3 = tr_read<v_rd_off(D0, 3, 1)>(vb);
    asm volatile("s_waitcnt lgkmcnt(0)" ::: "memory"); SBAR();
#define PK(L, H) (bf16x8){L[0], L[1], L[2], L[3], H[0], H[1], H[2], H[3]}
    od = __builtin_amdgcn_mfma_f32_32x32x16_bf16(PK(l0, h0), pa0, od, 0, 0, 0);
    od = __builtin_amdgcn_mfma_f32_32x32x16_bf16(PK(l1, h1), pa1, od, 0, 0, 0);
    od = __builtin_amdgcn_mfma_f32_32x32x16_bf16(PK(l2, h2), pa2, od, 0, 0, 0);
    od = __builtin_amdgcn_mfma_f32_32x32x16_bf16(PK(l3, h3), pa3, od, 0, 0, 0);
#undef PK
}
__device__ __forceinline__ void partialSM(f32x16& p0, f32x16& p1, float& m_reg, float& alpha) {
    float pmax = p0[0];
#pragma unroll
    for (int r = 1; r < 16; ++r) pmax = fmaxf(pmax, p0[r]);
#pragma unroll
    for (int r = 0; r < 16; ++r) pmax = fmaxf(pmax, p1[r]);
    { auto rr = __builtin_amdgcn_permlane32_swap(__float_as_uint(pmax), __float_as_uint(pmax), false, false); pmax = fmaxf(__uint_as_float(rr[0]), __uint_as_float(rr[1])); }
    float mn;
    if (__builtin_expect(__all(pmax - m_reg <= THR2), 1)) { mn = m_reg; alpha = 1.f; }
    else { mn = fmaxf(m_reg, pmax); alpha = __builtin_amdgcn_exp2f(m_reg - mn); m_reg = mn; }
#pragma unroll
    for (int r = 0; r < 16; ++r) { p0[r] = __builtin_amdgcn_exp2f(p0[r] - mn); p1[r] = __builtin_amdgcn_exp2f(p1[r] - mn); }
}
__device__ __forceinline__ void finishSM(const f32x16& p0, const f32x16& p1, float alpha, float& l_reg, bf16x8& pa0, bf16x8& pa1, bf16x8& pa2, bf16x8& pa3) {
    float ps = 0.f;
#pragma unroll
    for (int r = 0; r < 16; ++r) ps += p0[r];
#pragma unroll
    for (int r = 0; r < 16; ++r) ps += p1[r];
    { auto rr = __builtin_amdgcn_permlane32_swap(__float_as_uint(ps), __float_as_uint(ps), false, false); ps = __uint_as_float(rr[0]) + __uint_as_float(rr[1]); }
    l_reg = l_reg * alpha + ps;
#define PK4(P, BASE, OUT) do { unsigned a0 = pk2(P[BASE + 0], P[BASE + 1]), a1 = pk2(P[BASE + 2], P[BASE + 3]); \
    unsigned b0 = pk2(P[BASE + 4], P[BASE + 5]), b1 = pk2(P[BASE + 6], P[BASE + 7]); \
    auto r0 = __builtin_amdgcn_permlane32_swap(a0, b0, false, false); auto r1 = __builtin_amdgcn_permlane32_swap(a1, b1, false, false); \
    u32x4 w = {r0[0], r1[0], r0[1], r1[1]}; OUT = __builtin_bit_cast(bf16x8, w); } while (0)
    PK4(p0, 0, pa0); PK4(p0, 8, pa1); PK4(p1, 0, pa2); PK4(p1, 8, pa3);
#undef PK4
}
template <int DQK>
__device__ __forceinline__ void attn_pass(const bf16* __restrict__ Qb, int ldq, const bf16* __restrict__ Kh, int ldk, const bf16* __restrict__ Vh, int ldv, LAS unsigned char* lds, f32x16 (&o)[4]) {
    constexpr int NKS = DQK / 16, KROWB = DQK * 2, KBYTES = 64 * KROWB, SLOT = KBYTES + 16384, KP = KBYTES / 8192, NP = KP + 2, NT = SEQ / 64;
    int tid_ = threadIdx.x; asm volatile("" : "+v"(tid_));
    const int tid = tid_, lane = tid & 63, wid = rfl(tid >> 6), r32 = lane & 31, hi = lane >> 5;
    const unsigned lds0 = (unsigned)(uintptr_t)lds;
    unsigned ksrc[KP], vsrc[2];
#pragma unroll
    for (int q = 0; q < KP; ++q) { const int ob = (wid + 8 * q) * 1024 + 16 * lane, r = ob / KROWB, cc = ((ob - r * KROWB) >> 4) ^ ((r >> 1) & 7); ksrc[q] = (unsigned)(r * ldk + cc * 8); }
#pragma unroll
    for (int q = 0; q < 2; ++q) { const int ob = (wid + 8 * q) * 1024 + 16 * lane, st = ob >> 9, kk = (st >> 2) * 8 + ((ob & 511) >> 6), cc = (st & 3) * 32 + ((ob & 63) >> 1);
        const int k = (kk & ~0xC) | ((kk & 4) << 1) | ((kk & 8) >> 1); vsrc[q] = (unsigned)(k * ldv + cc); }
#define DMA_TILE(t, slot) do { const bf16* kt_ = Kh + (size_t)(t) * 64 * ldk; const bf16* vt_ = Vh + (size_t)(t) * 64 * ldv; const unsigned base_ = lds0 + (unsigned)(slot) * SLOT + (unsigned)wid * 1024u; \
    _Pragma("unroll") for (int q = 0; q < KP; ++q) glds16(kt_ + ksrc[q], (unsigned)rfl((int)(base_ + q * 8192))); \
    _Pragma("unroll") for (int q = 0; q < 2; ++q) glds16(vt_ + vsrc[q], (unsigned)rfl((int)(base_ + KBYTES + q * 8192))); } while (0)
    bf16x8 qr[NKS]; const bf16* Qw = Qb + (size_t)(wid * 32 + r32) * ldq + hi * 8;
#pragma unroll
    for (int d0 = 0; d0 < NKS; ++d0) qr[d0] = *(const bf16x8*)(Qw + d0 * 16);
    DMA_TILE(0, 0); DMA_TILE(1, 1);
    int koffs[4];
#pragma unroll
    for (int j = 0; j < 4; ++j) koffs[j] = r32 * KROWB + (((2 * j + hi) ^ ((r32 >> 1) & 7)) << 4);
    const int vb0 = (int)lds0 + KBYTES + v_rd_base(lane);
    float m_reg = -1e30f, l_reg = 0.f;
#pragma unroll
    for (int d = 0; d < 4; ++d) o[d] = f32x16{};
    asm volatile("s_waitcnt vmcnt(%0)" :: "n"(NP) : "memory"); __builtin_amdgcn_s_barrier(); asm volatile("" ::: "memory");
#pragma unroll
    for (int d0 = 0; d0 < NKS; ++d0) asm volatile("" : "+v"(qr[d0]));
    int slot = 0;
    for (int t = 0; t < NT; ++t) {
        const int s2 = slot == 0 ? 2 : slot - 1;
        if (t + 2 < NT) DMA_TILE(t + 2, s2);
        const LAS unsigned char* ks = lds + slot * SLOT;
        f32x16 p0 = f32x16{}, p1 = f32x16{};
#pragma unroll
        for (int d0 = 0; d0 < NKS; ++d0) {
            const bf16x8 b0 = *(const LAS bf16x8*)(ks + koffs[d0 & 3] + (d0 >> 2) * 128);
            const bf16x8 b1 = *(const LAS bf16x8*)(ks + koffs[d0 & 3] + (d0 >> 2) * 128 + 32 * KROWB);
            p0 = __builtin_amdgcn_mfma_f32_32x32x16_bf16(b0, qr[d0], p0, 0, 0, 0);
            p1 = __builtin_amdgcn_mfma_f32_32x32x16_bf16(b1, qr[d0], p1, 0, 0, 0);
            if ((d0 & 3) == 3) SBAR();
        }
        float alpha; partialSM(p0, p1, m_reg, alpha);
        if (__any(alpha < 1.f)) {
#pragma unroll
            for (int d = 0; d < 4; ++d) o[d] = o[d] * alpha; }
        bf16x8 pa0, pa1, pa2, pa3; finishSM(p0, p1, alpha, l_reg, pa0, pa1, pa2, pa3); SBAR();
        const int vb = vb0 + slot * SLOT;
        pv_one<0>(o[0], vb, pa0, pa1, pa2, pa3); pv_one<1>(o[1], vb, pa0, pa1, pa2, pa3); pv_one<2>(o[2], vb, pa0, pa1, pa2, pa3); pv_one<3>(o[3], vb, pa0, pa1, pa2, pa3);
        if (t + 2 < NT) asm volatile("s_waitcnt vmcnt(%0) lgkmcnt(0)" :: "n"(NP) : "memory"); else asm volatile("s_waitcnt vmcnt(0) lgkmcnt(0)" ::: "memory");
        __builtin_amdgcn_s_barrier(); asm volatile("" ::: "memory");
        slot = slot == 2 ? 0 : slot + 1;
    }
#undef DMA_TILE
    const float rl = __builtin_amdgcn_rcpf(l_reg);
#pragma unroll
    for (int d = 0; d < 4; ++d) o[d] = o[d] * rl;
}
#undef SBAR
}
__device__ __forceinline__ void store_o_row(bf16* rowp, const att::f32x16 (&o)[4], float sc, int hi) {
#pragma unroll
    for (int d = 0; d < 4; ++d)
#pragma unroll
        for (int g = 0; g < 4; ++g) { u32x2 w; w.x = pk2(o[d][4 * g] * sc, o[d][4 * g + 1] * sc); w.y = pk2(o[d][4 * g + 2] * sc, o[d][4 * g + 3] * sc); *(u32x2*)(rowp + 32 * d + 8 * g + 4 * hi) = w; }
}
__device__ __forceinline__ void phase_attn(const Ctx& c, LAS unsigned char* lds) {
    int tid_ = threadIdx.x; asm volatile("" : "+v"(tid_));
    const int tid = tid_, lane = tid & 63, wid = rfl(tid >> 6), r32 = lane & 31, hi = lane >> 5;
    const int G = gridDim.x, bx = blockIdx.x, vcu = (G % 8 == 0) ? (bx % 8) * (G / 8) + bx / 8 : bx;
    const float lam = __builtin_bit_cast(float, __hip_atomic_load(WSP(unsigned, WS_LAM), __ATOMIC_RELAXED, __HIP_MEMORY_SCOPE_AGENT));
    bf16* MIX = WSP(bf16, WS_MIX);
    for (int u = vcu; u < NB * 8 * 8; u += G) {
        const int bh = u >> 3, qb = u & 7, b = bh >> 3, h = bh & 7, row0 = b * SEQ + qb * 256, kb = b * SEQ;
        att::f32x16 o[4];
        att::attn_pass<64>(WSP(bf16, WS_QD) + (size_t)row0 * 1024 + h * 128, 1024, WSP(bf16, WS_KD) + (size_t)kb * 1024 + h * 128, 1024, WSP(bf16, WS_VD) + (size_t)kb * 1024 + h * 128, 1024, lds, o);
        {
            f32x4* st = (f32x4*)(WSP(float, WS_OST) + (size_t)(u * 8 + wid) * 4096) + lane;
#pragma unroll
            for (int d = 0; d < 4; ++d)
#pragma unroll
                for (int g = 0; g < 4; ++g) { *st = (f32x4){o[d][4 * g], o[d][4 * g + 1], o[d][4 * g + 2], o[d][4 * g + 3]}; st += 64; asm volatile("" : "+v"(st)); }
        }
        att::attn_pass<64>(WSP(bf16, WS_QD) + (size_t)row0 * 1024 + h * 128 + 64, 1024, WSP(bf16, WS_KD) + (size_t)kb * 1024 + h * 128 + 64, 1024, WSP(bf16, WS_VD) + (size_t)kb * 1024 + h * 128, 1024, lds, o);
        {
            const f32x4* st = (const f32x4*)(WSP(float, WS_OST) + (size_t)(u * 8 + wid) * 4096) + lane; float s = 0.f;
#pragma unroll
            for (int d = 0; d < 4; ++d)
#pragma unroll
                for (int g = 0; g < 4; ++g) { const f32x4 a = *st; st += 64; asm volatile("" : "+v"(st));
#pragma unroll
                    for (int j = 0; j < 4; ++j) { const float v = a[j] - lam * o[d][4 * g + j]; o[d][4 * g + j] = v; s += v * v; } }
            { auto rr = __builtin_amdgcn_permlane32_swap(__float_as_uint(s), __float_as_uint(s), false, false); s = __uint_as_float(rr[0]) + __uint_as_float(rr[1]); }
            const float rstd = 1.0f / sqrtf(s * (1.f / 128.f) + EPS);
            store_o_row(MIX + (size_t)(row0 + wid * 32 + r32) * DM + h * 128, o, rstd, hi);
        }
        att::attn_pass<192>(WSP(bf16, WS_QM) + (size_t)row0 * NQB + h * 192, NQB, WSP(bf16, WS_KM) + (size_t)kb * NQB + h * 192, NQB, WSP(bf16, WS_VM) + (size_t)kb * 1024 + h * 128, 1024, lds, o);
        store_o_row(MIX + (size_t)(row0 + wid * 32 + r32) * DM + 1024 + h * 128, o, 1.f, hi);
    }
}
__device__ __forceinline__ void phase_final(const Ctx& c) {
    const int tid = threadIdx.x, lane = tid & 63, wave = rfl(tid >> 6);
    const int gw = blockIdx.x * 8 + wave, NGW = gridDim.x * 8;
    const f32x4* ssq = (const f32x4*)WSP(float, WS_SSQ3);
    for (int row = gw; row < MT; row += NGW) {
        const f32x4 s0 = ssq[(size_t)row * 2], s1 = ssq[(size_t)row * 2 + 1];
        const float rstd = 1.0f / sqrtf(((s0[0] + s0[1]) + (s0[2] + s0[3]) + (s1[0] + s1[1]) + (s1[2] + s1[3])) * (1.f / DM) + EPS);
        f32x4* xr = (f32x4*)(c.out + (size_t)row * DM) + lane;
#pragma unroll
        for (int j = 0; j < 8; ++j) { const f32x4 g = *(const f32x4*)(c.g_fin + 4 * lane + 256 * j); xr[64 * j] = xr[64 * j] * rstd * g; }
    }
}


constexpr int CW_BAR = 4096;
constexpr int MISC_OFF = 131072 + 384;
#define XB_TMO      128
#define XB_XCNT(j)  (256  + 64 * (j))
#define XB_XSUB(j)  (1280 + 64 * (j))
#define XB_XGEN(j)  (2304 + 64 * (j))
#define XB_TOP      3328
#define XB_TOPGEN   3392
#define XCD_BAR_WORDS 3456
#define XB_SPIN_CAP (1u << 18)

__device__ __forceinline__ unsigned xb_ld(unsigned* p)              { return __hip_atomic_load(p, __ATOMIC_RELAXED, __HIP_MEMORY_SCOPE_AGENT); }
__device__ __forceinline__ unsigned xb_add(unsigned* p, unsigned v) { return __hip_atomic_fetch_add(p, v, __ATOMIC_RELAXED, __HIP_MEMORY_SCOPE_AGENT); }
__device__ __forceinline__ unsigned xb_xcc_id() { return (unsigned)__builtin_amdgcn_s_getreg((3 << 11) | 20) & 0xFu; }
#define XB_SPIN(cond, bar) do { unsigned _sp = 0; while (cond) { __builtin_amdgcn_s_sleep(1); \
    if ((++_sp & 255u) == 0u) { if (xb_ld(&(bar)[XB_TMO])) break; if (_sp > XB_SPIN_CAP) { atomicAdd(&(bar)[XB_TMO], 1u); break; } } } } while (0)

struct XcdBarrier {
    unsigned* bar; unsigned x;
    volatile LAS unsigned* st;
};

__device__ __forceinline__ XcdBarrier xcd_barrier_post(unsigned* bar, volatile LAS unsigned* st) {
    XcdBarrier b; b.bar = bar; b.x = xb_xcc_id(); b.st = st;
    if (threadIdx.x == 0) (void)xb_add(&bar[XB_XCNT(b.x)], 1u);
    return b;
}
__device__ __forceinline__ void xcd_barrier_complete(unsigned* bar, unsigned x, unsigned& nloc, unsigned& nx) {
    const unsigned G = gridDim.x * gridDim.y * gridDim.z;
    unsigned sum, cnt, mine, sp = 0u;
    for (;;) {
        sum = 0u; cnt = 0u; mine = 0u;
#pragma unroll
        for (unsigned j = 0; j < 16; ++j) { const unsigned c = xb_ld(&bar[XB_XCNT(j)]); sum += c; cnt += (c > 0u) ? 1u : 0u; mine = (j == x) ? c : mine; }
        if (sum == G) break;
        __builtin_amdgcn_s_sleep(1);
        if ((++sp & 255u) == 0u) { if (xb_ld(&bar[XB_TMO])) break; if (sp > XB_SPIN_CAP) { atomicAdd(&bar[XB_TMO], 1u); break; } }
    }
    nloc = mine > 0u ? mine : 1u; nx = cnt > 0u ? cnt : 1u;
}

__device__ __forceinline__ void xcd_barrier(const XcdBarrier& b) {
    asm volatile("s_waitcnt vmcnt(0)" ::: "memory");
    __syncthreads();
    if (threadIdx.x == 0) {
        unsigned* bar = b.bar;
        __builtin_amdgcn_s_waitcnt(0);
        unsigned nloc = b.st[0], nx = b.st[1];
        if (nloc == 0u) { xcd_barrier_complete(bar, b.x, nloc, nx); b.st[0] = nloc; b.st[1] = nx; }
        const unsigned old = xb_add(&bar[XB_XSUB(b.x)], 1u);
        const unsigned gen = old / nloc;
        if (old + 1u == (gen + 1u) * nloc) {
            __builtin_amdgcn_fence(__ATOMIC_RELEASE, "agent");
            asm volatile("s_waitcnt vmcnt(0)" ::: "memory");
            const unsigned og = xb_add(&bar[XB_TOP], 1u);
            const unsigned tg = og / nx;
            if (og + 1u == (tg + 1u) * nx) xb_add(&bar[XB_TOPGEN], 1u);
            else XB_SPIN(xb_ld(&bar[XB_TOPGEN]) == tg, bar);
            __builtin_amdgcn_fence(__ATOMIC_ACQUIRE, "agent");
            xb_add(&bar[XB_XGEN(b.x)], 1u);
            asm volatile("s_waitcnt vmcnt(0)" ::: "memory");
        } else {
            XB_SPIN(xb_ld(&bar[XB_XGEN(b.x)]) == gen, bar);
            __builtin_amdgcn_fence(__ATOMIC_ACQUIRE, "agent");
            asm volatile("s_waitcnt vmcnt(0)" ::: "memory");
        }
    }
    __syncthreads();
}


#ifndef MK_LAUNCHES
#define MK_LAUNCHES 1
#endif
#define KERNEL_HEAD extern __shared__ __attribute__((aligned(16))) unsigned char lds_raw[]; LAS unsigned char* lds = (LAS unsigned char*)lds_raw;
template <int PH> __device__ __forceinline__ void run_phase(const Ctx& c, LAS unsigned char* lds) {
    if (PH == 0) phase_p0a(c, lds);
    if (PH == 1) phase_p0b(c);
    if (PH == 2) phase_p0c(c, lds);
    if (PH == 3) { EpiIn E{c}; run_gemm(lds, WSP(bf16, WS_XN), WSP(bf16, WS_WIN), MT, NINP, DM, E); }
    if (PH == 4) { EpiQB E{c}; run_gemm(lds, WSP(bf16, WS_QLAT), WSP(bf16, WS_WQB), MT, NQB, QLR, E); }
    if (PH == 5) { EpiKVB E{c}; run_gemm(lds, WSP(bf16, WS_KVLAT), WSP(bf16, WS_WKVB), MT, NKVB, KVLR, E); }
#if defined(ATTN_NAIVE)
    if (PH == 6) phase_attn_naive(c, lds);
#else
    if (PH == 6) phase_attn(c, lds);
#endif
    if (PH == 7) { EpiOut E{c}; run_gemm(lds, WSP(bf16, WS_MIX), WSP(bf16, WS_WOUT), MT, DM, DM, E); }
    if (PH == 8) { EpiF1 E{c}; run_gemm(lds, WSP(bf16, WS_A2), WSP(bf16, WS_W1), MT, DFF, DM, E); }
    if (PH == 9) { EpiF2 E{c}; run_gemm(lds, WSP(bf16, WS_H), WSP(bf16, WS_W2), MT, DM, DFF, E); }
    if (PH == 10) phase_final(c);
}
#if MK_LAUNCHES == 1
__global__ void __launch_bounds__(512, 2) mk_fwd(Ctx c) {
    KERNEL_HEAD
    volatile LAS unsigned* misc = (volatile LAS unsigned*)(lds + MISC_OFF);
    if (threadIdx.x < 4) misc[threadIdx.x] = 0u;
    __syncthreads();
    XcdBarrier bar = xcd_barrier_post((unsigned*)(c.ws + WS_CTL) + CW_BAR, misc);
    run_phase<0>(c, lds); xcd_barrier(bar);
    run_phase<1>(c, lds); xcd_barrier(bar);
    run_phase<2>(c, lds); xcd_barrier(bar);
    run_phase<3>(c, lds); xcd_barrier(bar);
    run_phase<4>(c, lds); run_phase<5>(c, lds); xcd_barrier(bar);
    run_phase<6>(c, lds); xcd_barrier(bar);
    run_phase<7>(c, lds); xcd_barrier(bar);
    run_phase<8>(c, lds); xcd_barrier(bar);
    run_phase<9>(c, lds); xcd_barrier(bar);
    run_phase<10>(c, lds);
}
#else
template <int PH> __global__ void __launch_bounds__(512, 2) k_phase(Ctx c) { KERNEL_HEAD run_phase<PH>(c, lds); }
#endif

extern "C" void kernel_launch(void* const* d_in, const int* in_sizes, int n_in, void* d_out, int out_size, void* d_ws, size_t ws_size, hipStream_t stream) {
    static int ok = 0;
    if (ok == 0) {
        if (n_in != 21 || in_sizes[0] != MT * DM || out_size != MT * DM || ws_size < WS_END) { fprintf(stderr, "kernel_launch: unexpected shapes: n_in %d in0 %d out %d ws %zu (need >= %zu)\n", n_in, n_in > 0 ? in_sizes[0] : -1, out_size, ws_size, (size_t)WS_END); ok = -1; return; }
#if MK_LAUNCHES == 1
        int dev = 0, cus = 0;
        if (hipGetDevice(&dev) != hipSuccess || hipDeviceGetAttribute(&cus, hipDeviceAttributeMultiprocessorCount, dev) != hipSuccess || cus < 256) { fprintf(stderr, "kernel_launch: needs a 256-CU device (one resident workgroup per CU), found %d\n", cus); ok = -1; return; }
        if (hipFuncSetAttribute((const void*)mk_fwd, hipFuncAttributeMaxDynamicSharedMemorySize, LDS_BYTES) != hipSuccess) { fprintf(stderr, "kernel_launch: hipFuncSetAttribute failed\n"); ok = -1; return; }
#else
        const void* ks[] = {(const void*)k_phase<0>, (const void*)k_phase<1>, (const void*)k_phase<2>, (const void*)k_phase<3>, (const void*)k_phase<4>, (const void*)k_phase<5>, (const void*)k_phase<6>, (const void*)k_phase<7>, (const void*)k_phase<8>, (const void*)k_phase<9>, (const void*)k_phase<10>};
        for (const void* k : ks) if (hipFuncSetAttribute(k, hipFuncAttributeMaxDynamicSharedMemorySize, LDS_BYTES) != hipSuccess) { fprintf(stderr, "kernel_launch: hipFuncSetAttribute failed\n"); ok = -1; return; }
#endif
        ok = 1;
    }
    if (ok < 0) return;
    Ctx c{};
    c.x = (const float*)d_in[0]; c.c = (const float*)d_in[1]; c.pos = (const int*)d_in[2]; c.w_ada = (const float*)d_in[3]; c.b_ada = (const float*)d_in[4]; c.g_mix = (const float*)d_in[5];
    c.w_in = (const float*)d_in[6]; c.lq1 = (const float*)d_in[7]; c.lk1 = (const float*)d_in[8]; c.lq2 = (const float*)d_in[9]; c.lk2 = (const float*)d_in[10]; c.g_dsub = (const float*)d_in[11];
    c.g_qa = (const float*)d_in[12]; c.w_qb = (const float*)d_in[13]; c.g_kva = (const float*)d_in[14]; c.w_kvb = (const float*)d_in[15]; c.w_out = (const float*)d_in[16]; c.g_ffn = (const float*)d_in[17];
    c.w_ff1 = (const float*)d_in[18]; c.w_ff2 = (const float*)d_in[19]; c.g_fin = (const float*)d_in[20]; c.out = (float*)d_out; c.ws = (unsigned char*)d_ws;
    const dim3 grid(256), block(512);
#if MK_LAUNCHES == 1
    if (hipMemsetAsync((char*)d_ws + WS_CTL, 0, 65536, stream) != hipSuccess) { fprintf(stderr, "kernel_launch: hipMemsetAsync failed\n"); return; }
    hipLaunchKernelGGL(mk_fwd, grid, block, LDS_BYTES, stream, c);
#else
    hipLaunchKernelGGL(k_phase<0>, grid, block, LDS_BYTES, stream, c); hipLaunchKernelGGL(k_phase<1>, grid, block, LDS_BYTES, stream, c); hipLaunchKernelGGL(k_phase<2>, grid, block, LDS_BYTES, stream, c);
    hipLaunchKernelGGL(k_phase<3>, grid, block, LDS_BYTES, stream, c); hipLaunchKernelGGL(k_phase<4>, grid, block, LDS_BYTES, stream, c); hipLaunchKernelGGL(k_phase<5>, grid, block, LDS_BYTES, stream, c);
    hipLaunchKernelGGL(k_phase<6>, grid, block, LDS_BYTES, stream, c); hipLaunchKernelGGL(k_phase<7>, grid, block, LDS_BYTES, stream, c); hipLaunchKernelGGL(k_phase<8>, grid, block, LDS_BYTES, stream, c);
    hipLaunchKernelGGL(k_phase<9>, grid, block, LDS_BYTES, stream, c); hipLaunchKernelGGL(k_phase<10>, grid, block, LDS_BYTES, stream, c);
#endif
    const hipError_t le = hipPeekAtLastError();
    if (le != hipSuccess) fprintf(stderr, "kernel_launch: launch failed: %s\n", hipGetErrorName(le));
}
```
